# Optimizing an MI355X kernel written in HIP

```python
import jax, jax.numpy as jnp
from jax import lax
import numpy as np

D_MODEL = 1024
BATCH = 4
SEQ = 8192
DEPTH = 2

GRID_W = 64
HEAD_DIM = 64
NA_HEADS = D_MODEL // 256
NA_WIDTH = NA_HEADS * HEAD_DIM
NA_KR_MAX = 8
NA_KC = 16
MLA_HEADS = D_MODEL // 128
MLA_NOPE = 64
MLA_ROPE = 32
MLA_V = 64
MLA_Q_RANK = 384
MLA_KV_RANK = 256
MLA_WIDTH = MLA_HEADS * MLA_V
ROPE_THETA = 10000.0
Q_BLOCK = 128
CONV_WIDTH = D_MODEL // 4
CONV_K = 3
D_MIX = NA_WIDTH + MLA_WIDTH + CONV_WIDTH
D_IN = 3 * NA_WIDTH + MLA_Q_RANK + MLA_KV_RANK + MLA_ROPE + 3 * CONV_WIDTH
OUT_GROUPS = D_MIX // HEAD_DIM
D_FF = -(-8 * D_MODEL // (3 * 256)) * 256
EPS = 1e-6

kernel_name = 'hybrid_na_mla_shortconv_encoder'


def rms_norm(x, g):
    xf = x.astype(jnp.float32)
    y = xf * lax.rsqrt(jnp.mean(xf * xf, axis=-1, keepdims=True) + EPS)
    return (y * g.astype(jnp.float32)).astype(x.dtype)


def ada_norm(x, g, shift, scale):
    return rms_norm(x, g) * (1 + scale) + shift


def rope_tables(positions):
    inv = ROPE_THETA ** (-jnp.arange(0, MLA_ROPE, 2, dtype=jnp.float32) / MLA_ROPE)
    ang = positions.astype(jnp.float32)[..., None] * inv
    return jnp.cos(ang), jnp.sin(ang)


def apply_rope(x, cos, sin):
    xf = x.astype(jnp.float32)
    x1, x2 = jnp.split(xf, 2, axis=-1)
    return jnp.concatenate([x1 * cos - x2 * sin, x2 * cos + x1 * sin], axis=-1).astype(x.dtype)


def neighbourhood_attention(q, k, v, rpb):
    b, t, h, dh = q.shape
    rows = t // GRID_W
    kr = min(NA_KR_MAX, rows)
    kc = NA_KC
    qg = q.reshape(b, rows, GRID_W, h, dh)
    kg = k.reshape(b, rows, GRID_W, h, dh)
    vg = v.reshape(b, rows, GRID_W, h, dh)
    r = jnp.arange(rows)
    row_start = jnp.clip(r - kr // 2, 0, rows - kr)
    row_idx = row_start[:, None] + jnp.arange(kr)[None, :]
    k_band = kg[:, row_idx]
    v_band = vg[:, row_idx]
    s = jnp.einsum('brqhd,brjwhd->bhrqjw', qg, k_band).astype(jnp.float32) * (dh ** -0.5)
    cols = jnp.arange(GRID_W)
    col_start = jnp.clip(cols - kc // 2, 0, GRID_W - kc)
    col_ok = (cols[None, :] >= col_start[:, None]) & (cols[None, :] < col_start[:, None] + kc)
    dr_i = row_idx - r[:, None] + NA_KR_MAX - 1
    dc_i = jnp.clip(cols[None, :] - cols[:, None] + kc - 1, 0, 2 * kc - 2)
    bias = rpb[:, dr_i[:, None, :, None], dc_i[None, :, None, :]]
    s = jnp.where(col_ok[:, None, :], s + bias.astype(jnp.float32)[None], -jnp.inf)
    p = jax.nn.softmax(s.reshape(b, h, rows, GRID_W, kr * GRID_W), axis=-1)
    p = p.reshape(s.shape).astype(v.dtype)
    o = jnp.einsum('bhrqjw,brjwhd->brqhd', p, v_band)
    return o.reshape(b, t, h * dh)


def latent_attention(c_q, c_kv, k_rope, q_a_g, kv_a_g, w_uq, w_ukv, qn_g, kn_g, qr_g, kr_g, cos, sin):
    b, t, _ = c_q.shape
    q = (rms_norm(c_q, q_a_g) @ w_uq).reshape(b, t, MLA_HEADS, MLA_NOPE + MLA_ROPE)
    kv = (rms_norm(c_kv, kv_a_g) @ w_ukv).reshape(b, t, MLA_HEADS, MLA_NOPE + MLA_V)
    q_nope = rms_norm(q[..., :MLA_NOPE], qn_g)
    q_rope = apply_rope(rms_norm(q[..., MLA_NOPE:], qr_g), cos[:, :, None], sin[:, :, None])
    k_nope = rms_norm(kv[..., :MLA_NOPE], kn_g)
    v = kv[..., MLA_NOPE:]
    k_r = apply_rope(rms_norm(k_rope, kr_g), cos, sin)
    scale = (MLA_NOPE + MLA_ROPE) ** -0.5
    nb = t // Q_BLOCK

    def to_blocks(a):
        return jnp.moveaxis(a.reshape(b, nb, Q_BLOCK, *a.shape[2:]), 1, 0)

    def block(qs):
        qn, qr = qs
        s = jnp.einsum('bqhd,bkhd->bhqk', qn, k_nope) + jnp.einsum('bqhr,bkr->bhqk', qr, k_r)
        p = jax.nn.softmax(s.astype(jnp.float32) * scale, axis=-1).astype(v.dtype)
        return jnp.einsum('bhqk,bkhd->bqhd', p, v)

    o = lax.map(block, (to_blocks(q_nope), to_blocks(q_rope)))
    return jnp.moveaxis(o, 0, 1).reshape(b, t, MLA_WIDTH)


def short_conv(x_in, gate_b, gate_c, conv_w, conv_b):
    u = gate_c * x_in
    y = lax.conv_general_dilated(u, conv_w[:, None, :], window_strides=(1,),
                                 padding=((CONV_K // 2, CONV_K // 2),),
                                 dimension_numbers=('NWC', 'WIO', 'NWC'),
                                 feature_group_count=CONV_WIDTH) + conv_b
    return gate_b * y


def setup_inputs(seed: int = 0) -> dict:
    key = jax.random.key(seed)
    ks = jax.random.split(key, 24)
    f32 = jnp.float32

    def dense(k, shape, fan_in, mult=1.0):
        return jax.random.normal(k, shape, f32) * (mult * fan_in ** -0.5)

    def gain(k, shape):
        return 1.0 + 0.05 * jax.random.normal(k, shape, f32)

    def small(k, shape, s):
        return s * jax.random.normal(k, shape, f32)

    L = DEPTH
    return {
        'x': jax.random.normal(ks[0], (BATCH, SEQ, D_MODEL), f32),
        'c': jax.random.normal(ks[1], (BATCH, D_MODEL), f32),
        'positions': jnp.broadcast_to(jnp.arange(SEQ, dtype=jnp.int32), (BATCH, SEQ)),
        'norm1_g': gain(ks[2], (L, D_MODEL)),
        'norm2_g': gain(ks[3], (L, D_MODEL)),
        'w_ada': dense(ks[4], (L, D_MODEL, 6 * D_MODEL), D_MODEL, 0.5),
        'b_ada': small(ks[5], (L, 6 * D_MODEL), 0.02),
        'w_in': dense(ks[6], (L, D_MODEL, D_IN), D_MODEL),
        'na_q_g': gain(ks[7], (L, HEAD_DIM)),
        'na_k_g': gain(ks[8], (L, HEAD_DIM)),
        'na_rpb': small(ks[9], (L, NA_HEADS, 2 * NA_KR_MAX - 1, 2 * NA_KC - 1), 0.05),
        'mla_q_a_g': gain(ks[10], (L, MLA_Q_RANK)),
        'mla_kv_a_g': gain(ks[11], (L, MLA_KV_RANK)),
        'mla_w_uq': dense(ks[12], (L, MLA_Q_RANK, MLA_HEADS * (MLA_NOPE + MLA_ROPE)), MLA_Q_RANK),
        'mla_w_ukv': dense(ks[13], (L, MLA_KV_RANK, MLA_HEADS * (MLA_NOPE + MLA_V)), MLA_KV_RANK),
        'mla_qn_g': gain(ks[14], (L, MLA_NOPE)),
        'mla_kn_g': gain(ks[15], (L, MLA_NOPE)),
        'mla_qr_g': gain(ks[16], (L, MLA_ROPE)),
        'mla_kr_g': gain(ks[17], (L, MLA_ROPE)),
        'conv_w': dense(ks[18], (L, CONV_K, CONV_WIDTH), CONV_K),
        'conv_b': small(ks[19], (L, CONV_WIDTH), 0.02),
        'out_norm_g': gain(ks[20], (L, D_MIX)),
        'w_out': dense(ks[21], (L, D_MIX, D_MODEL), D_MIX),
        'w_gu': dense(ks[22], (L, D_MODEL, 2 * D_FF), D_MODEL),
        'w_down': dense(ks[23], (L, D_FF, D_MODEL), D_FF),
    }


def reference(x, c, positions, norm1_g, norm2_g, w_ada, b_ada, w_in, na_q_g, na_k_g, na_rpb,
              mla_q_a_g, mla_kv_a_g, mla_w_uq, mla_w_ukv, mla_qn_g, mla_kn_g, mla_qr_g, mla_kr_g,
              conv_w, conv_b, out_norm_g, w_out, w_gu, w_down):
    b, t, _ = x.shape
    cos, sin = rope_tables(positions)
    c_act = jax.nn.silu(c)
    i0 = 3 * NA_WIDTH
    i1 = i0 + MLA_Q_RANK
    i2 = i1 + MLA_KV_RANK
    i3 = i2 + MLA_ROPE
    for l in range(DEPTH):
        mod = c_act @ w_ada[l] + b_ada[l]
        sh1, sc1, g1, sh2, sc2, g2 = jnp.split(mod[:, None, :], 6, axis=-1)
        h = ada_norm(x, norm1_g[l], sh1, sc1)
        proj = h @ w_in[l]
        na_qkv, c_q, c_kv, k_rope, conv_in = jnp.split(proj, [i0, i1, i2, i3], axis=-1)
        q, k, v = jnp.split(na_qkv, 3, axis=-1)
        q = rms_norm(q.reshape(b, t, NA_HEADS, HEAD_DIM), na_q_g[l])
        k = rms_norm(k.reshape(b, t, NA_HEADS, HEAD_DIM), na_k_g[l])
        v = v.reshape(b, t, NA_HEADS, HEAD_DIM)
        y_na = neighbourhood_attention(q, k, v, na_rpb[l])
        y_mla = latent_attention(c_q, c_kv, k_rope, mla_q_a_g[l], mla_kv_a_g[l], mla_w_uq[l],
                                 mla_w_ukv[l], mla_qn_g[l], mla_kn_g[l], mla_qr_g[l], mla_kr_g[l],
                                 cos, sin)
        x_in, gate_b, gate_c = jnp.split(conv_in, 3, axis=-1)
        y_conv = short_conv(x_in, gate_b, gate_c, conv_w[l], conv_b[l])
        mixed = jnp.concatenate([y_na, y_mla, y_conv], axis=-1)
        mixed = rms_norm(mixed.reshape(b, t, OUT_GROUPS, HEAD_DIM),
                         out_norm_g[l].reshape(OUT_GROUPS, HEAD_DIM)).reshape(b, t, D_MIX)
        x = x + g1 * (mixed @ w_out[l])
        h2 = ada_norm(x, norm2_g[l], sh2, sc2)
        gt, up = jnp.split(h2 @ w_gu[l], 2, axis=-1)
        x = x + g2 * ((jax.nn.silu(gt) * up) @ w_down[l])
    return x
```

```cpp
#include <hip/hip_runtime.h>
#include <hip/hip_cooperative_groups.h>
#include <cstdio>
#include <cstdint>
#include <cmath>
namespace cg = cooperative_groups;
namespace pg8 {
#define PG8_LAS __attribute__((address_space(3)))
typedef unsigned short bf16_t;
typedef short bf16x8 __attribute__((ext_vector_type(8)));
typedef float f32x4 __attribute__((ext_vector_type(4)));
typedef unsigned u32x4 __attribute__((ext_vector_type(4)));
constexpr int BM = 256, BK = 64, HALF = 128, HTB = HALF * BK * 2  , STAGE_BYTES = 8 * HTB, NXCD = 8, WGM = 8;

__host__ __device__ __forceinline__ int lds_byte(int r, int c) { const int st = (r >> 4) * 2 + (c >> 5), rr = r & 15, cc = c & 31, ob = rr * 64 + cc * 2; return st * 1024 + (ob ^ (((ob >> 9) & 1) << 5)); }
__host__ __device__ __forceinline__ void stage_rc(int b, int& R, int& C) { const int st = b / 1024, sb = b % 1024, swz = sb ^ (((sb >> 9) & 1) << 5); R = (st >> 1) * 16 + swz / 64; C = (st & 1) * 32 + (swz % 64) / 2; }
__host__ __device__ __forceinline__ int perm32(int rho) { const int n = rho >> 4, i = rho & 15; return 8 * (i >> 2) + 4 * n + (i & 3); }

struct Unit { int pm, pn; };
struct Gemm { const bf16_t* A; const bf16_t* Bt; int M, N, K, lda; };

struct StaticOrder {
    int nM, nN, nwg, G, c;
    __host__ __device__ void init(int M, int N, int G_, int c_) { nM = M / BM; nN = N / BM; nwg = nM * nN; G = G_; c = c_; }
    __host__ __device__ bool next(int i, Unit& u) const {
        const long L = (long)i * G + c; if (L >= nwg) return false;
        int wgid = (int)L; { const int q = nwg / NXCD, r = nwg % NXCD, xcd = wgid % NXCD, off = wgid / NXCD; wgid = (xcd < r ? xcd * (q + 1) : r * (q + 1) + (xcd - r) * q) + off; }
        const int nig = WGM * nN, gid = wgid / nig, fm = gid * WGM, gsz = (nM - fm) < WGM ? (nM - fm) : WGM;
        u.pm = fm + ((wgid % nig) % gsz); u.pn = (wgid % nig) / gsz; return true;
    }
    __device__ __forceinline__ void a_ready(const Unit&) const {}
    __device__ __forceinline__ void done(const Unit&) const {}
};
__device__ __forceinline__ unsigned cvt_pk_bf16(float lo, float hi) { unsigned r; asm volatile("v_cvt_pk_bf16_f32 %0, %1, %2" : "=v"(r) : "v"(lo), "v"(hi)); return r; }
template <class Epi, class Sched, bool ALIGN_EPI = false, bool SP2 = false>
__device__ __forceinline__ void gemm_phase(PG8_LAS unsigned char* lds, const Gemm g, const Sched& S, const Epi& E) {
    int tid_ = threadIdx.x; asm volatile("" : "+v"(tid_));
    const int tid = tid_, wid = __builtin_amdgcn_readfirstlane(tid >> 6), lane = tid & 63, wr = wid >> 2, wc = wid & 3, fr = lane & 15, fq = lane >> 4;
    const int K = g.K, nt = K / BK;
    unsigned voffA[2], voffB[2];
#pragma unroll
    for (int i = 0; i < 2; ++i) { int R, C; stage_rc(tid * 16 + i * 8192, R, C); const int Rb = Epi::PERM ? ((R & ~31) + perm32(R & 31)) : R;
        voffA[i] = (unsigned)(R * g.lda + C) * 2u; voffB[i] = (unsigned)(Rb * K + C) * 2u; }
    const size_t kstep = (size_t)(BK * 2);
    const size_t hstep = (size_t)HALF * K * 2;
    const size_t tstep = 2 * hstep; const size_t hstepA = (size_t)HALF * g.lda * 2, tstepA = 2 * hstepA;
    const unsigned ldsw = (unsigned)wid * 1024u;
    const int aoff = lds_byte(wr * 64 + fr, fq * 8), boff = lds_byte(wc * 32 + fr, fq * 8);
#define PG8_SA(b, h) (((b) * 2 + (h)) * HTB)
#define PG8_SB(b, h) ((4 + (b) * 2 + (h)) * HTB)
#define PG8_STAGE(bufoff, gbase, voff) do { _Pragma("unroll") for (int _i = 0; _i < 2; ++_i) \
        __builtin_amdgcn_global_load_lds((const unsigned*)((const char*)(gbase) + (voff)[_i]), (PG8_LAS unsigned*)(lds + (bufoff) + ldsw + _i * 8192), 16, 0, 0); } while (0)
#define PG8_LDA(dst, b, h) do { _Pragma("unroll") for (int m = 0; m < 4; ++m) _Pragma("unroll") for (int k = 0; k < 2; ++k) dst[m][k] = *(const PG8_LAS bf16x8*)(lds + PG8_SA(b, h) + aoff + m * 2048 + k * 1024); } while (0)
#define PG8_LDB(dst, b, h) do { _Pragma("unroll") for (int n = 0; n < 2; ++n) _Pragma("unroll") for (int k = 0; k < 2; ++k) dst[n][k] = *(const PG8_LAS bf16x8*)(lds + PG8_SB(b, h) + boff + n * 2048 + k * 1024); } while (0)
#define PG8_MMA(ai, bj, At, Bt) do { __builtin_amdgcn_s_setprio(1); _Pragma("unroll") for (int m = 0; m < 4; ++m) _Pragma("unroll") for (int n = 0; n < 2; ++n) _Pragma("unroll") for (int k = 0; k < 2; ++k) \
        acc[ai][bj][m][n] = __builtin_amdgcn_mfma_f32_16x16x32_bf16(Bt[n][k], At[m][k], acc[ai][bj][m][n], 0, 0, 0); __builtin_amdgcn_s_setprio(0); } while (0)
#define PG8_WAIT_V(n) asm volatile("s_waitcnt vmcnt(" #n ")" ::: "memory")
#define PG8_WAIT_L(n) asm volatile("s_waitcnt lgkmcnt(" #n ")" ::: "memory")
#define PG8_BAR __builtin_amdgcn_s_barrier()
#define PG8_SCHED __builtin_amdgcn_sched_barrier(0)
    Unit cur, nxt; int ui = 0;
    if (!S.next(0, cur)) return;
    f32x4 acc[2][2][4][2];
#pragma unroll
    for (int a = 0; a < 2; ++a)
#pragma unroll
        for (int b = 0; b < 2; ++b)
#pragma unroll
            for (int m = 0; m < 4; ++m)
#pragma unroll
                for (int n = 0; n < 2; ++n) acc[a][b][m][n] = (f32x4){0.f, 0.f, 0.f, 0.f};
    bf16x8 At[4][2], B0[2][2], B1[2][2];
    const char* cA = (const char*)g.A + (size_t)cur.pm * tstepA; const char* cB = (const char*)g.Bt + (size_t)cur.pn * tstep;
    S.a_ready(cur);
    if constexpr (SP2) {
        PG8_STAGE(PG8_SB(0, 0), cB, voffB); PG8_STAGE(PG8_SB(0, 1), cB + hstep, voffB); PG8_STAGE(PG8_SA(0, 0), cA, voffA); PG8_STAGE(PG8_SA(0, 1), cA + hstepA, voffA);
        if (wr == 1) PG8_BAR;
        PG8_WAIT_V(2); PG8_BAR;
        PG8_STAGE(PG8_SB(1, 0), cB + kstep, voffB); PG8_STAGE(PG8_SA(1, 0), cA + kstep, voffA); PG8_STAGE(PG8_SB(1, 1), cB + hstep + kstep, voffB);
        PG8_WAIT_V(6); PG8_BAR;
    } else {
        PG8_STAGE(PG8_SB(0, 0), cB, voffB); PG8_STAGE(PG8_SA(0, 0), cA, voffA); PG8_STAGE(PG8_SB(0, 1), cB + hstep, voffB); PG8_STAGE(PG8_SA(0, 1), cA + hstepA, voffA);
        if (wr == 1) PG8_BAR;
        PG8_WAIT_V(4); PG8_BAR;
        PG8_STAGE(PG8_SB(1, 0), cB + kstep, voffB); PG8_STAGE(PG8_SA(1, 0), cA + kstep, voffA); PG8_STAGE(PG8_SB(1, 1), cB + hstep + kstep, voffB);
        PG8_WAIT_V(6); PG8_BAR;
    }
    for (;;) {
        const bool has_next = S.next(ui + 1, nxt);
        const char* nA = has_next ? (const char*)g.A + (size_t)nxt.pm * tstepA : cA; const char* nB = has_next ? (const char*)g.Bt + (size_t)nxt.pn * tstep : cB;
        for (int t = 0; t < nt; t += 2) {
            const bool last = (t == nt - 2);
            const char* a1 = cA + (size_t)(t + 1) * kstep;
            const char* a2 = last ? nA : cA + (size_t)(t + 2) * kstep; const char* b2 = last ? nB : cB + (size_t)(t + 2) * kstep;
            const char* a3 = a2 + kstep; const char* b3 = b2 + kstep;
            if (last && has_next) S.a_ready(nxt);
            if constexpr (SP2) {
            PG8_LDB(B0, 0, 0); PG8_LDB(B1, 0, 1); PG8_SCHED; PG8_LDA(At, 0, 0); PG8_STAGE(PG8_SA(1, 1), a1 + hstepA, voffA);
            PG8_WAIT_V(8); PG8_WAIT_L(0); PG8_BAR; PG8_MMA(0, 0, At, B0); PG8_MMA(0, 1, At, B1); PG8_BAR; PG8_SCHED;
            PG8_LDA(At, 0, 1); PG8_STAGE(PG8_SB(0, 0), b2, voffB); PG8_STAGE(PG8_SB(0, 1), b2 + hstep, voffB); PG8_STAGE(PG8_SA(0, 0), a2, voffA);
            PG8_WAIT_V(8); PG8_WAIT_L(0); PG8_BAR; PG8_MMA(1, 0, At, B0); PG8_MMA(1, 1, At, B1); PG8_BAR; PG8_SCHED;
            PG8_LDB(B0, 1, 0); PG8_LDB(B1, 1, 1); PG8_SCHED; PG8_LDA(At, 1, 0); PG8_STAGE(PG8_SA(0, 1), a2 + hstepA, voffA);
            PG8_WAIT_V(8); PG8_WAIT_L(0); PG8_BAR; PG8_MMA(0, 0, At, B0); PG8_MMA(0, 1, At, B1); PG8_BAR; PG8_SCHED;
            PG8_LDA(At, 1, 1); PG8_STAGE(PG8_SB(1, 0), b3, voffB); PG8_STAGE(PG8_SB(1, 1), b3 + hstep, voffB); PG8_STAGE(PG8_SA(1, 0), a3, voffA);
            PG8_WAIT_V(8); PG8_WAIT_L(0); PG8_BAR; PG8_MMA(1, 0, At, B0); PG8_MMA(1, 1, At, B1); PG8_BAR; PG8_SCHED;
            } else {
            PG8_LDB(B0, 0, 0); PG8_SCHED; PG8_LDA(At, 0, 0); PG8_STAGE(PG8_SA(1, 1), a1 + hstepA, voffA);
            PG8_WAIT_L(8); PG8_BAR; PG8_WAIT_L(0); PG8_MMA(0, 0, At, B0); PG8_BAR; PG8_SCHED;
            PG8_LDB(B1, 0, 1); PG8_STAGE(PG8_SB(0, 0), b2, voffB);
            PG8_BAR; PG8_WAIT_L(0); PG8_MMA(0, 1, At, B1); PG8_BAR;
            PG8_LDA(At, 0, 1); PG8_STAGE(PG8_SA(0, 0), a2, voffA);
            PG8_BAR; PG8_WAIT_L(0); PG8_MMA(1, 0, At, B0); PG8_BAR; PG8_SCHED;
            PG8_STAGE(PG8_SB(0, 1), b2 + hstep, voffB);
            PG8_WAIT_V(6); PG8_BAR; PG8_MMA(1, 1, At, B1); PG8_BAR;
            PG8_LDB(B0, 1, 0); PG8_SCHED; PG8_LDA(At, 1, 0); PG8_STAGE(PG8_SA(0, 1), a2 + hstepA, voffA);
            PG8_WAIT_L(8); PG8_BAR; PG8_WAIT_L(0); PG8_MMA(0, 0, At, B0); PG8_BAR; PG8_SCHED;
            PG8_LDB(B1, 1, 1); PG8_STAGE(PG8_SB(1, 0), b3, voffB);
            PG8_BAR; PG8_WAIT_L(0); PG8_MMA(0, 1, At, B1); PG8_BAR;
            PG8_LDA(At, 1, 1); PG8_STAGE(PG8_SA(1, 0), a3, voffA);
            PG8_BAR; PG8_WAIT_L(0); PG8_MMA(1, 0, At, B0); PG8_BAR; PG8_SCHED;
            PG8_STAGE(PG8_SB(1, 1), b3 + hstep, voffB);
            PG8_WAIT_V(6); PG8_BAR; PG8_MMA(1, 1, At, B1); PG8_BAR;
            }
        }
        if constexpr (ALIGN_EPI) { if (wr == 0) PG8_BAR; }
        if constexpr (!Epi::AFTER_DRAIN) { E(acc, cur, wr, wc, fr, fq); S.done(cur); }
        if (!has_next) break;
#pragma unroll
        for (int a = 0; a < 2; ++a)
#pragma unroll
            for (int b = 0; b < 2; ++b)
#pragma unroll
                for (int m = 0; m < 4; ++m)
#pragma unroll
                    for (int n = 0; n < 2; ++n) acc[a][b][m][n] = (f32x4){0.f, 0.f, 0.f, 0.f};
        cur = nxt; cA = nA; cB = nB; ++ui;
        if constexpr (ALIGN_EPI) { if (wr == 1) PG8_BAR; }
    }
    PG8_WAIT_V(0);
    if constexpr (!ALIGN_EPI) { if (wr == 0) PG8_BAR; }
    PG8_BAR;
    if constexpr (Epi::AFTER_DRAIN) { E.fused(acc, cur, wr, wc, fr, fq, lds, wid, lane); S.done(cur); }
#undef PG8_SA
#undef PG8_SB
#undef PG8_STAGE
#undef PG8_LDA
#undef PG8_LDB
#undef PG8_MMA
#undef PG8_WAIT_V
#undef PG8_WAIT_L
#undef PG8_BAR
#undef PG8_SCHED
}
}

constexpr int BATCH = 4, T = 8192, D = 1024, M = BATCH * T, DEPTH = 2;
constexpr int D_IN = 2208, DFF = 2816, NMOD = 6 * D;
constexpr int N_IN = 2304, N_UQ = 768, K_UQ = 384, N_UKV = 1024, K_UKV = 256, N_GU = 5632;
constexpr float EPS = 1e-6f, LOG2E = 1.4426950408889634f;
constexpr int NWAVES = 8, NTHREADS = 512;

#define LAS __attribute__((address_space(3)))
typedef unsigned short bf16_t;
typedef float f32x4 __attribute__((ext_vector_type(4)));
typedef unsigned u32x4 __attribute__((ext_vector_type(4)));
typedef unsigned u32x2 __attribute__((ext_vector_type(2)));

constexpr size_t MiB = 1u << 20;
constexpr size_t WS_MOD = 0;
constexpr size_t WS_BAR = 512 * 1024;
constexpr size_t WS_COS = 1 * MiB, WS_SIN = 3 * MiB;
constexpr size_t WS_SSQ = 5 * MiB;
constexpr size_t WS_BIASIN = 5 * MiB + 512 * 1024, WS_BIASGU = WS_BIASIN + 2 * 4 * 2304 * 4;
constexpr size_t WS_AVEC = 5 * MiB + 832 * 1024;
constexpr size_t WS_W = 6 * MiB, W_LAYER = 26 * MiB;
constexpr size_t WO_IN = 0, WO_UQ = 4 * MiB + 512 * 1024, WO_UKV = 5 * MiB + 256 * 1024, WO_OUT = 6 * MiB, WO_GU = 8 * MiB, WO_DOWN = 19 * MiB;
constexpr size_t WS_H = 58 * MiB;
constexpr size_t WS_XA = 122 * MiB;
constexpr size_t WS_QNA = 250 * MiB, WS_KNA = 266 * MiB, WS_VNA = 282 * MiB;
constexpr size_t WS_P = 298 * MiB;
constexpr size_t WS_QN = 122 * MiB, WS_KN = 154 * MiB, WS_QR = 186 * MiB, WS_V = 202 * MiB, WS_KR = 234 * MiB;
constexpr size_t WS_MIX = 412 * MiB, WS_SSQ2 = 476 * MiB, WS_END = 477 * MiB;
constexpr size_t WS_ACT = 250 * MiB;

__device__ __forceinline__ unsigned f2bf(float f) { unsigned u = __builtin_bit_cast(unsigned, f); return (u + 0x7fffu + ((u >> 16) & 1u)) >> 16; }
__device__ __forceinline__ unsigned pk2(float lo, float hi) { return f2bf(lo) | (f2bf(hi) << 16); }
__device__ __forceinline__ float bf_lo(unsigned u) { return __builtin_bit_cast(float, u << 16); }
__device__ __forceinline__ float bf_hi(unsigned u) { return __builtin_bit_cast(float, u & 0xffff0000u); }
__device__ __forceinline__ float wave_sum(float v) {
#pragma unroll
    for (int o = 1; o < 64; o <<= 1) v += __shfl_xor(v, o);
    return v;
}
#define LDS_WAIT() asm volatile("s_waitcnt lgkmcnt(0)" ::: "memory")
template <int CTRL> __device__ __forceinline__ float dpp_xmax(float x) { return fmaxf(x, __int_as_float(__builtin_amdgcn_update_dpp(__float_as_int(x), __float_as_int(x), CTRL, 0xf, 0xf, false))); }
__device__ __forceinline__ float wave_max(float x) {
    x = dpp_xmax<0xB1>(x); x = dpp_xmax<0x4E>(x); x = dpp_xmax<0x141>(x); x = dpp_xmax<0x140>(x);
    auto a = __builtin_amdgcn_permlane16_swap(__float_as_uint(x), __float_as_uint(x), false, false); x = fmaxf(__uint_as_float(a[0]), __uint_as_float(a[1]));
    auto b = __builtin_amdgcn_permlane32_swap(__float_as_uint(x), __float_as_uint(x), false, false); return fmaxf(__uint_as_float(b[0]), __uint_as_float(b[1]));
}
__device__ __forceinline__ float sum_fq(float x) {
    auto a = __builtin_amdgcn_permlane16_swap(__float_as_uint(x), __float_as_uint(x), false, false); x = __uint_as_float(a[0]) + __uint_as_float(a[1]);
    auto b = __builtin_amdgcn_permlane32_swap(__float_as_uint(x), __float_as_uint(x), false, false); return __uint_as_float(b[0]) + __uint_as_float(b[1]);
}

__device__ __forceinline__ int src_col(int id, int c) {
    const int pn = c >> 8, r = c & 255, bj = r >> 7, wc = (r >> 5) & 3, jj = r & 31, lc = 64 * wc + 32 * bj + jj;
    switch (id) {
    case 0:
        if (pn < 3) return 256 * pn + lc;
        if (pn == 3) return 768 + lc;
        if (pn == 4) return lc < 128 ? 1024 + lc : (lc < 160 ? 1408 + (lc - 128) : -1);
        if (pn == 5) return 1152 + lc;
        return 1440 + 256 * (pn - 6) + lc;
    case 1:
        if (pn < 2) return (4 * pn + wc) * 96 + 32 * bj + jj;
        return (2 * wc + bj) * 96 + 64 + jj;
    case 2:
        if (pn < 2) return (4 * pn + wc) * 128 + 32 * bj + jj;
        return (4 * (pn - 2) + wc) * 128 + 64 + 32 * bj + jj;
    case 3: return 256 * pn + lc;
    case 4: return 128 * pn + 32 * wc + jj + (bj ? DFF : 0);
    default: return 256 * pn + lc;
    }
}
__device__ __forceinline__ void transpose_item(const float* __restrict__ W, int K, int Nsrc, int id, bf16_t* __restrict__ WT, LAS float* scr, int item, int nblk, int lane, const float* __restrict__ kgain = nullptr) {
    const int kb = item / nblk, nb = item % nblk, k0 = 64 * kb, n0 = 32 * nb;
    const int sc = src_col(id, n0 + (lane & 31));
    { const float* wp = W + (size_t)(k0 + (lane >> 5)) * Nsrc + (sc >= 0 ? sc : 0);
      float v[32];
#pragma unroll
      for (int i = 0; i < 32; ++i) v[i] = wp[(size_t)(2 * i) * Nsrc];
#pragma unroll
      for (int i = 0; i < 32; ++i) scr[(2 * i + (lane >> 5)) * 33 + (lane & 31)] = sc >= 0 ? v[i] * (kgain ? kgain[k0 + 2 * i + (lane >> 5)] : 1.f) : 0.f; }
    LDS_WAIT();
    const int c = lane & 7;
#pragma unroll
    for (int j = 0; j < 4; ++j) { const int n = (lane >> 3) + 8 * j; const LAS float* s = scr + (8 * c) * 33 + n;
        u32x4 o; o.x = pg8::cvt_pk_bf16(s[0 * 33], s[1 * 33]); o.y = pg8::cvt_pk_bf16(s[2 * 33], s[3 * 33]); o.z = pg8::cvt_pk_bf16(s[4 * 33], s[5 * 33]); o.w = pg8::cvt_pk_bf16(s[6 * 33], s[7 * 33]);
        *(u32x4*)(WT + (size_t)(n0 + n) * K + k0 + 8 * c) = o; }
    LDS_WAIT();
}

__device__ __forceinline__ float other_half(float x) { auto r = __builtin_amdgcn_permlane32_swap(__float_as_uint(x), __float_as_uint(x), false, false);
    return __uint_as_float((threadIdx.x & 32) ? r[0] : r[1]); }
__device__ __forceinline__ void epi_store_heads(const f32x4 (&acc)[2][2][4][2], int row0, int fq, bool norm, const float* __restrict__ g, float scl, bf16_t* __restrict__ dst, int ld, const float* __restrict__ rssq = nullptr, float invk = 0.f) {
#pragma unroll
    for (int ai = 0; ai < 2; ++ai)
#pragma unroll
        for (int m = 0; m < 4; ++m) {
            float r = 1.f, rl = 1.f;
            if (rssq) rl = rsqrtf(rssq[row0 + ai * 128 + m * 16] * invk + EPS);
            if (norm) { float ss = 0.f;
#pragma unroll
                for (int bj = 0; bj < 2; ++bj)
#pragma unroll
                    for (int n = 0; n < 2; ++n) { const f32x4 v = acc[ai][bj][m][n]; ss += (v[0] * v[0] + v[1] * v[1]) + (v[2] * v[2] + v[3] * v[3]); }
                ss = sum_fq(ss);
                r = rsqrtf(ss * rl * rl * (1.f / 64.f) + EPS) * scl; }
            r *= rl;
            bf16_t* rowp = dst + (size_t)(row0 + ai * 128 + m * 16) * ld + 8 * fq;
#pragma unroll
            for (int bj = 0; bj < 2; ++bj) {
                f32x4 g0 = {1.f, 1.f, 1.f, 1.f}, g1 = g0;
                if (norm) { g0 = *(const f32x4*)(g + 32 * bj + 8 * fq); g1 = *(const f32x4*)(g + 32 * bj + 8 * fq + 4); }
                const f32x4 v0 = acc[ai][bj][m][0] * r * g0, v1 = acc[ai][bj][m][1] * r * g1;
                u32x4 w; w.x = pg8::cvt_pk_bf16(v0[0], v0[1]); w.y = pg8::cvt_pk_bf16(v0[2], v0[3]); w.z = pg8::cvt_pk_bf16(v1[0], v1[1]); w.w = pg8::cvt_pk_bf16(v1[2], v1[3]);
                *(u32x4*)(rowp + 32 * bj) = w; }
        }
}
__device__ __forceinline__ void epi_apply_norm(f32x4 (&acc)[2][2][4][2], int row0, int gcol0  , const float* __restrict__ ssq, const float* __restrict__ bias) {
    f32x4 bv[2][2];
#pragma unroll
    for (int bj = 0; bj < 2; ++bj)
#pragma unroll
        for (int n = 0; n < 2; ++n) bv[bj][n] = *(const f32x4*)(bias + gcol0 + 128 * bj + 4 * n);
#pragma unroll
    for (int ai = 0; ai < 2; ++ai)
#pragma unroll
        for (int m = 0; m < 4; ++m) { const float rs = rsqrtf(ssq[row0 + ai * 128 + m * 16] * (1.f / D) + EPS);
#pragma unroll
            for (int bj = 0; bj < 2; ++bj)
#pragma unroll
                for (int n = 0; n < 2; ++n) acc[ai][bj][m][n] = acc[ai][bj][m][n] * rs + bv[bj][n]; }
}
struct EpiIn {
    static constexpr bool PERM = true, AFTER_DRAIN = false;
    unsigned char* ws; int l; const float *qg, *kg, *krg; float qscale;
    __device__ __forceinline__ void operator()(f32x4 (&acc)[2][2][4][2], const pg8::Unit& u, int wr, int wc, int fr, int fq) const {
        const int row0 = u.pm * 256 + wr * 64 + fr;
        bf16_t* qna = (bf16_t*)(ws + WS_QNA); bf16_t* kna = (bf16_t*)(ws + WS_KNA); bf16_t* vna = (bf16_t*)(ws + WS_VNA); bf16_t* P = (bf16_t*)(ws + WS_P); bf16_t* KR = (bf16_t*)(ws + WS_KR);
        const float* ssq = (const float*)(ws + WS_SSQ) + (size_t)(2 * l) * M; const float* bias = (const float*)(ws + WS_BIASIN) + (size_t)l * 4 * N_IN;
        float* ssq_cq = (float*)(ws + WS_SSQ2) + (size_t)(2 * l) * M; float* ssq_ckv = ssq_cq + M;
        const float* cosT = (const float*)(ws + WS_COS); const float* sinT = (const float*)(ws + WS_SIN);
        epi_apply_norm(acc, row0, u.pn * 256 + wc * 32 + fq * 8, ssq, bias + (size_t)(u.pm >> 5) * N_IN);
        bf16_t* dst; int ld = 256; bool norm = false; const float* g = qg; float scl = 1.f;
        if (u.pn == 0) { dst = qna + wc * 64; norm = true; scl = qscale; }
        else if (u.pn == 1) { dst = kna + wc * 64; norm = true; g = kg; }
        else if (u.pn == 2) { dst = vna + wc * 64; }
        else { dst = P + (u.pn - 3) * 256 + wc * 64; ld = 1536; }
        epi_store_heads(acc, row0, fq, norm, g, scl, dst, ld);
        if (u.pn >= 3 && u.pn <= 5) {
            const bool is_cq = (u.pn == 3) || (u.pn == 4 && wc < 2);
            if (is_cq || u.pn == 5) {
                float* sd = is_cq ? ssq_cq : ssq_ckv;
#pragma unroll
                for (int ai = 0; ai < 2; ++ai)
#pragma unroll
                    for (int m = 0; m < 4; ++m) { float ss = 0.f;
#pragma unroll
                        for (int bj = 0; bj < 2; ++bj)
#pragma unroll
                            for (int n = 0; n < 2; ++n) { const f32x4 v = acc[ai][bj][m][n]; ss += (v[0] * v[0] + v[1] * v[1]) + (v[2] * v[2] + v[3] * v[3]); }
                        ss = sum_fq(ss);
                        if (fq == 0) atomicAdd(sd + row0 + ai * 128 + m * 16, ss); }
            } else if (wc == 2) {
                const f32x4 ga = *(const f32x4*)(krg + 8 * fq), gb = *(const f32x4*)(krg + 8 * fq + 4);
#pragma unroll
                for (int ai = 0; ai < 2; ++ai)
#pragma unroll
                    for (int m = 0; m < 4; ++m) { const size_t row = (size_t)(row0 + ai * 128 + m * 16);
                        const f32x4 x0 = acc[ai][0][m][0], x1 = acc[ai][0][m][1];
                        float ss = (x0[0] * x0[0] + x0[1] * x0[1]) + (x0[2] * x0[2] + x0[3] * x0[3]) + (x1[0] * x1[0] + x1[1] * x1[1]) + (x1[2] * x1[2] + x1[3] * x1[3]);
                        ss = sum_fq(ss);
                        const float r = rsqrtf(ss * (1.f / 32.f) + EPS);
                        const f32x4 y0 = x0 * r * ga, y1 = x1 * r * gb;
                        f32x4 q0, q1;
#pragma unroll
                        for (int i = 0; i < 4; ++i) { q0[i] = other_half(y0[i]); q1[i] = other_half(y1[i]); }
                        const f32x4 c0 = *(const f32x4*)(cosT + row * 16 + 8 * (fq & 1)), c1 = *(const f32x4*)(cosT + row * 16 + 8 * (fq & 1) + 4);
                        const f32x4 s0 = *(const f32x4*)(sinT + row * 16 + 8 * (fq & 1)), s1 = *(const f32x4*)(sinT + row * 16 + 8 * (fq & 1) + 4);
                        const f32x4 o0 = (fq < 2) ? y0 * c0 - q0 * s0 : y0 * c0 + q0 * s0, o1 = (fq < 2) ? y1 * c1 - q1 * s1 : y1 * c1 + q1 * s1;
                        u32x4 w; w.x = pg8::cvt_pk_bf16(o0[0], o0[1]); w.y = pg8::cvt_pk_bf16(o0[2], o0[3]); w.z = pg8::cvt_pk_bf16(o1[0], o1[1]); w.w = pg8::cvt_pk_bf16(o1[2], o1[3]);
                        *(u32x4*)(KR + row * 32 + 8 * fq) = w; }
            }
        }
    }
};
struct EpiHeads {
    static constexpr bool PERM = true, AFTER_DRAIN = false;
    bf16_t *A, *B; const float* g; const float* ssq; float scl, invk; int ldB, pad_;
    __device__ __forceinline__ void operator()(const f32x4 (&acc)[2][2][4][2], const pg8::Unit& u, int wr, int wc, int fr, int fq) const {
        const int row0 = u.pm * 256 + wr * 64 + fr;
        const bool norm = u.pn < 2;
        bf16_t* dst = norm ? A + (4 * u.pn + wc) * 64 : B + (4 * (u.pn - 2) + wc) * 64;
        epi_store_heads(acc, row0, fq, norm, g, scl, dst, norm ? 512 : ldB, ssq, invk);
    }
};
struct EpiRes {
    static constexpr bool PERM = true, AFTER_DRAIN = false;
    const float* xin; float* xout; const float* gate;
    bf16_t* hn; const float* an; float* ssqn;
    __device__ __forceinline__ void operator()(const f32x4 (&acc)[2][2][4][2], const pg8::Unit& u, int wr, int wc, int fr, int fq) const {
        const int row0 = u.pm * 256 + wr * 64 + fr;
        const float* gp = gate + (size_t)(u.pm >> 5) * NMOD;
        float sq[2][4];
#pragma unroll
        for (int ai = 0; ai < 2; ++ai)
#pragma unroll
            for (int m = 0; m < 4; ++m) sq[ai][m] = 0.f;
#pragma unroll
        for (int bj = 0; bj < 2; ++bj) {
            const int col = u.pn * 256 + wc * 64 + bj * 32 + fq * 8;
            const f32x4 gv0 = *(const f32x4*)(gp + col), gv1 = *(const f32x4*)(gp + col + 4);
            f32x4 av0 = {0.f, 0.f, 0.f, 0.f}, av1 = av0; if (hn) { av0 = *(const f32x4*)(an + (size_t)(u.pm >> 5) * D + col); av1 = *(const f32x4*)(an + (size_t)(u.pm >> 5) * D + col + 4); }
#pragma unroll
            for (int ai = 0; ai < 2; ++ai)
#pragma unroll
                for (int m = 0; m < 4; ++m) { const size_t off = (size_t)(row0 + ai * 128 + m * 16) * D + col;
                    const f32x4 x0 = *(const f32x4*)(xin + off) + gv0 * acc[ai][bj][m][0], x1 = *(const f32x4*)(xin + off + 4) + gv1 * acc[ai][bj][m][1];
                    *(f32x4*)(xout + off) = x0; *(f32x4*)(xout + off + 4) = x1;
                    if (hn) { const f32x4 h0 = x0 * av0, h1 = x1 * av1; u32x4 w; w.x = pg8::cvt_pk_bf16(h0[0], h0[1]); w.y = pg8::cvt_pk_bf16(h0[2], h0[3]); w.z = pg8::cvt_pk_bf16(h1[0], h1[1]); w.w = pg8::cvt_pk_bf16(h1[2], h1[3]);
                        *(u32x4*)(hn + off) = w;
                        sq[ai][m] += (x0[0] * x0[0] + x0[1] * x0[1]) + (x0[2] * x0[2] + x0[3] * x0[3]) + (x1[0] * x1[0] + x1[1] * x1[1]) + (x1[2] * x1[2] + x1[3] * x1[3]); } }
        }
        if (hn) {
#pragma unroll
            for (int ai = 0; ai < 2; ++ai)
#pragma unroll
                for (int m = 0; m < 4; ++m) { float s = sq[ai][m]; s = sum_fq(s);
                    if (fq == 0) atomicAdd(ssqn + row0 + ai * 128 + m * 16, s); }
        }
    }
};
__device__ __forceinline__ float silu_f(float x) { return x * __builtin_amdgcn_rcpf(1.f + __builtin_amdgcn_exp2f(-x * LOG2E)); }
struct EpiGU {
    static constexpr bool PERM = true, AFTER_DRAIN = false;
    bf16_t* act; const float *ssq, *bias;
    __device__ __forceinline__ void operator()(f32x4 (&acc)[2][2][4][2], const pg8::Unit& u, int wr, int wc, int fr, int fq) const {
        const int row0 = u.pm * 256 + wr * 64 + fr;
        epi_apply_norm(acc, row0, u.pn * 256 + wc * 32 + fq * 8, ssq, bias + (size_t)(u.pm >> 5) * N_GU);
#pragma unroll
        for (int ai = 0; ai < 2; ++ai)
#pragma unroll
            for (int m = 0; m < 4; ++m) {
                bf16_t* rowp = act + (size_t)(row0 + ai * 128 + m * 16) * DFF + u.pn * 128 + wc * 32 + fq * 8;
                float v[8];
#pragma unroll
                for (int n = 0; n < 2; ++n)
#pragma unroll
                    for (int i = 0; i < 4; ++i) v[4 * n + i] = silu_f(acc[ai][0][m][n][i]) * acc[ai][1][m][n][i];
                u32x4 w; w.x = pg8::cvt_pk_bf16(v[0], v[1]); w.y = pg8::cvt_pk_bf16(v[2], v[3]); w.z = pg8::cvt_pk_bf16(v[4], v[5]); w.w = pg8::cvt_pk_bf16(v[6], v[7]);
                *(u32x4*)rowp = w;
            }
    }
};

namespace att {
typedef short bf16x8 __attribute__((ext_vector_type(8)));
typedef short s16x4 __attribute__((ext_vector_type(4)));
typedef float f32x16 __attribute__((ext_vector_type(16)));
constexpr int KBUF = 64 * 208, OFF_K = 0, OFF_V = 2 * KBUF, OFF_BIAS = OFF_V + 2 * 8192, OFF_OST = 49152;
__device__ __forceinline__ s16x4 vtr(const LAS unsigned char* p) { return __builtin_bit_cast(s16x4, __builtin_amdgcn_ds_read_tr16_b64_v4i16((LAS s16x4*)p)); }
__device__ __forceinline__ float half_max(float m) { auto rr = __builtin_amdgcn_permlane32_swap(__float_as_uint(m), __float_as_uint(m), false, false); return fmaxf(__uint_as_float(rr[0]), __uint_as_float(rr[1])); }
__device__ __forceinline__ float half_sum(float m) { auto rr = __builtin_amdgcn_permlane32_swap(__float_as_uint(m), __float_as_uint(m), false, false); return __uint_as_float(rr[0]) + __uint_as_float(rr[1]); }

template <bool NA>
__device__ __forceinline__ void attn_unit(LAS unsigned char* lds, int b, int h, int ublk,
        const bf16_t* __restrict__ Qa, int ldq, const bf16_t* __restrict__ Qb,
        const bf16_t* __restrict__ Ka, int ldk, const bf16_t* __restrict__ Kb,
        const bf16_t* __restrict__ Vg, int ldv,
        const float* __restrict__ rpb, const float* __restrict__ og, bf16_t* __restrict__ outp,
        const float* __restrict__ cosT, const float* __restrict__ sinT, const float* __restrict__ qrg, float qrs,
        const float* __restrict__ kgn1, const float* __restrict__ kgn2) {
    constexpr int NDS = NA ? 4 : 6, KSTR = NA ? 144 : 208;
    int tid_ = threadIdx.x; asm volatile("" : "+v"(tid_));
    const int tid = tid_, lane = tid & 63, wid = __builtin_amdgcn_readfirstlane(tid >> 6), r32 = lane & 31, hi = lane >> 5;
    int t_lo, t_hi, w_lo, w_hi, qc = 0, cs = 0, R = 0; size_t tokq;
    if (NA) { const int R0 = 4 * ublk; R = R0 + (wid >> 1); qc = 32 * (wid & 1) + r32;
        t_lo = min(max(R0 - 4, 0), 120); t_hi = min(max(R0 - 1, 0), 120) + 8; w_lo = min(max(R - 4, 0), 120); w_hi = w_lo + 8;
        cs = min(max(qc - 8, 0), 48); tokq = (size_t)b * T + R * 64 + qc; }
    else { t_lo = 0; t_hi = T / 64; w_lo = 0; w_hi = T / 64; tokq = (size_t)b * T + ublk * 256 + wid * 32 + r32; }
    const int srow = tid >> 3, sc = tid & 7;
    const bf16_t* kg = Ka + ((size_t)b * T + srow) * ldk + h * 64 + sc * 8;
    const bf16_t* vg = Vg + ((size_t)b * T + srow) * ldv + h * 64 + sc * 8;
    const bf16_t* kg2 = NA ? Ka : Kb + ((size_t)b * T + (tid >> 2)) * 32 + (tid & 3) * 8;
    const int kdst = srow * KSTR + sc * 16, vdst = (sc >> 2) * 4096 + srow * 64 + (sc & 3) * 16, kdst2 = (tid >> 2) * KSTR + 128 + (tid & 3) * 16;
    const bool do_k2 = !NA && tid < 256;
    u32x4 kr, vr, kr2 = {0u, 0u, 0u, 0u};
    kr = *(const u32x4*)(kg + (size_t)t_lo * 64 * ldk); vr = *(const u32x4*)(vg + (size_t)t_lo * 64 * ldv);
    if (do_k2) kr2 = *(const u32x4*)(kg2 + (size_t)t_lo * 64 * 32);
    bf16x8 qf[NDS];
    { const bf16_t* qp = Qa + tokq * ldq + h * 64 + hi * 8;
#pragma unroll
      for (int ds = 0; ds < 4; ++ds) qf[ds] = *(const bf16x8*)(qp + ds * 16);
      if (!NA) { const bf16_t* qp2 = Qb + tokq * 256 + h * 32 + hi * 8;
          const u32x4 ua = *(const u32x4*)qp2, ub = *(const u32x4*)(qp2 + 16);
          float x1[8], x2[8]; float ss = 0.f;
#pragma unroll
          for (int i = 0; i < 4; ++i) { x1[2 * i] = bf_lo(ua[i]); x1[2 * i + 1] = bf_hi(ua[i]); x2[2 * i] = bf_lo(ub[i]); x2[2 * i + 1] = bf_hi(ub[i]); }
#pragma unroll
          for (int i = 0; i < 8; ++i) ss += x1[i] * x1[i] + x2[i] * x2[i];
          const float rs = rsqrtf(half_sum(ss) * (1.f / 32.f) + EPS) * qrs;
          u32x4 wa, wb;
#pragma unroll
          for (int i = 0; i < 4; ++i) {
              float o1[2], o2[2];
#pragma unroll
              for (int j = 0; j < 2; ++j) { const int e = 8 * hi + 2 * i + j; const float cc = cosT[tokq * 16 + e], sn = sinT[tokq * 16 + e];
                  const float y1 = x1[2 * i + j] * rs * qrg[e], y2 = x2[2 * i + j] * rs * qrg[16 + e];
                  o1[j] = y1 * cc - y2 * sn; o2[j] = y2 * cc + y1 * sn; }
              wa[i] = pg8::cvt_pk_bf16(o1[0], o1[1]); wb[i] = pg8::cvt_pk_bf16(o2[0], o2[1]); }
          qf[NDS - 2] = __builtin_bit_cast(bf16x8, wa); qf[NDS - 1] = __builtin_bit_cast(bf16x8, wb); } }
    if (NA) { if (tid < 480) { const int dr = tid >> 5, dc = tid & 31; ((LAS float*)(lds + OFF_BIAS))[tid] = dc < 31 ? rpb[dr * 31 + dc] * LOG2E : 0.f; } }
    float mref;
    { float qn2 = 0.f;
#pragma unroll
      for (int ds = 0; ds < NDS; ++ds) { const u32x4 u = __builtin_bit_cast(u32x4, qf[ds]);
#pragma unroll
          for (int i = 0; i < 4; ++i) { const float a = bf_lo(u[i]), bq = bf_hi(u[i]); qn2 += a * a + bq * bq; } }
      qn2 = half_sum(qn2);
      float g1 = kgn1[lane]; g1 *= g1;
      float g2 = 0.f; if (!NA) { g2 = kgn2[lane & 31]; g2 *= g2; }
      float bm = 0.f; if (NA) { for (int i = lane; i < 15 * 31; i += 64) bm = fmaxf(bm, rpb[i]); }
      g1 = wave_max(g1); g2 = wave_max(g2); if (NA) bm = wave_max(bm);
      mref = sqrtf(qn2 * (64.f * g1 + 32.f * g2)) * 1.02f + 1.f + bm * LOG2E; }
    f32x16 negm;
#pragma unroll
    for (int r = 0; r < 16; ++r) negm[r] = -mref;
    *(LAS u32x4*)(lds + OFF_K + kdst) = kr; *(LAS u32x4*)(lds + OFF_V + vdst) = vr;
    if (do_k2) *(LAS u32x4*)(lds + OFF_K + kdst2) = kr2;
    __syncthreads();
    float l_run = 0.f;
    f32x16 o0 = {}, o1 = {};
    const int pim = (r32 & 0x13) | ((r32 & 4) << 1) | ((r32 & 8) >> 1);
    const int koff = pim * KSTR + hi * 16;
    const int voff = (8 * hi + ((lane & 15) >> 2)) * 64 + (16 * ((lane >> 4) & 1) + 4 * (lane & 3)) * 2;
    for (int t = t_lo; t < t_hi; ++t) {
        const int cur = (t - t_lo) & 1;
        const bool more = t + 1 < t_hi;
        if (more) { kr = *(const u32x4*)(kg + (size_t)(t + 1) * 64 * ldk); vr = *(const u32x4*)(vg + (size_t)(t + 1) * 64 * ldv);
            if (do_k2) kr2 = *(const u32x4*)(kg2 + (size_t)(t + 1) * 64 * 32); }
        if (t >= w_lo && t < w_hi) {
            const LAS unsigned char* a0 = lds + OFF_K + cur * KBUF + koff;
            f32x16 p0, p1;
            bf16x8 kf[2 * NDS];
#pragma unroll
            for (int ds = 0; ds < NDS; ++ds) { kf[2 * ds] = *(const LAS bf16x8*)(a0 + ds * 32); kf[2 * ds + 1] = *(const LAS bf16x8*)(a0 + 32 * KSTR + ds * 32); }
            __builtin_amdgcn_sched_barrier(0);
#pragma unroll
            for (int ds = 0; ds < NDS; ++ds) {
                if (ds == 0) { p0 = __builtin_amdgcn_mfma_f32_32x32x16_bf16(kf[0], qf[0], negm, 0, 0, 0); p1 = __builtin_amdgcn_mfma_f32_32x32x16_bf16(kf[1], qf[0], negm, 0, 0, 0); }
                else { p0 = __builtin_amdgcn_mfma_f32_32x32x16_bf16(kf[2 * ds], qf[ds], p0, 0, 0, 0); p1 = __builtin_amdgcn_mfma_f32_32x32x16_bf16(kf[2 * ds + 1], qf[ds], p1, 0, 0, 0); }
            }
            const LAS unsigned char* va = lds + OFF_V + cur * 8192 + voff;
            s16x4 vl0[4], vh0[4], vl1[4], vh1[4];
#pragma unroll
            for (int s = 0; s < 4; ++s) { vl0[s] = vtr(va + s * 1024); vh0[s] = vtr(va + s * 1024 + 256); vl1[s] = vtr(va + 4096 + s * 1024); vh1[s] = vtr(va + 4096 + s * 1024 + 256); }
            __builtin_amdgcn_sched_barrier(0);
            if (NA) {
                const LAS float* bt = (const LAS float*)(lds + OFF_BIAS) + (t - R + 7) * 32;
#pragma unroll
                for (int r = 0; r < 16; ++r) {
                    const int kc0 = 16 * (r >> 3) + 8 * hi + (r & 7), kc1 = kc0 + 32;
                    const int i0 = min(max(kc0 - qc + 15, 0), 30), i1 = min(max(kc1 - qc + 15, 0), 30);
                    p0[r] = ((unsigned)(kc0 - cs) < 16u) ? p0[r] + bt[i0] : -1e30f;
                    p1[r] = ((unsigned)(kc1 - cs) < 16u) ? p1[r] + bt[i1] : -1e30f;
                }
            }
            float ps0 = 0.f, ps1 = 0.f;
#pragma unroll
            for (int r = 0; r < 16; ++r) { p0[r] = __builtin_amdgcn_exp2f(p0[r]); p1[r] = __builtin_amdgcn_exp2f(p1[r]); ps0 += p0[r]; ps1 += p1[r]; }
            l_run += ps0 + ps1;
            bf16x8 pb[4];
#pragma unroll
            for (int s = 0; s < 4; ++s) { const int bs = 8 * (s & 1); u32x4 w;
                if (s < 2) { w.x = pg8::cvt_pk_bf16(p0[bs], p0[bs + 1]); w.y = pg8::cvt_pk_bf16(p0[bs + 2], p0[bs + 3]); w.z = pg8::cvt_pk_bf16(p0[bs + 4], p0[bs + 5]); w.w = pg8::cvt_pk_bf16(p0[bs + 6], p0[bs + 7]); }
                else { w.x = pg8::cvt_pk_bf16(p1[bs], p1[bs + 1]); w.y = pg8::cvt_pk_bf16(p1[bs + 2], p1[bs + 3]); w.z = pg8::cvt_pk_bf16(p1[bs + 4], p1[bs + 5]); w.w = pg8::cvt_pk_bf16(p1[bs + 6], p1[bs + 7]); }
                pb[s] = __builtin_bit_cast(bf16x8, w); }
#pragma unroll
            for (int s = 0; s < 4; ++s) {
                const bf16x8 vf0 = {vl0[s][0], vl0[s][1], vl0[s][2], vl0[s][3], vh0[s][0], vh0[s][1], vh0[s][2], vh0[s][3]}, vf1 = {vl1[s][0], vl1[s][1], vl1[s][2], vl1[s][3], vh1[s][0], vh1[s][1], vh1[s][2], vh1[s][3]};
                o0 = __builtin_amdgcn_mfma_f32_32x32x16_bf16(vf0, pb[s], o0, 0, 0, 0);
                o1 = __builtin_amdgcn_mfma_f32_32x32x16_bf16(vf1, pb[s], o1, 0, 0, 0);
            }
        }
        if (more) { const int nb = cur ^ 1;
            *(LAS u32x4*)(lds + OFF_K + nb * KBUF + kdst) = kr; *(LAS u32x4*)(lds + OFF_V + nb * 8192 + vdst) = vr;
            if (do_k2) *(LAS u32x4*)(lds + OFF_K + nb * KBUF + kdst2) = kr2; }
        __syncthreads();
    }
    const float inv = 1.f / half_sum(l_run);
    float ss = 0.f;
#pragma unroll
    for (int r = 0; r < 16; ++r) { o0[r] *= inv; o1[r] *= inv; ss += o0[r] * o0[r] + o1[r] * o1[r]; }
    ss = half_sum(ss);
    const float rn = rsqrtf(ss * (1.f / 64.f) + EPS);
    LAS unsigned char* stg = lds + OFF_OST + wid * 4608;
#pragma unroll
    for (int rq = 0; rq < 4; ++rq) {
        const int d0 = 8 * rq + 4 * hi;
        const f32x4 g0 = *(const f32x4*)(og + d0), g1 = *(const f32x4*)(og + 32 + d0);
        u32x2 w0, w1;
        w0.x = pg8::cvt_pk_bf16(o0[4 * rq] * rn * g0[0], o0[4 * rq + 1] * rn * g0[1]); w0.y = pg8::cvt_pk_bf16(o0[4 * rq + 2] * rn * g0[2], o0[4 * rq + 3] * rn * g0[3]);
        w1.x = pg8::cvt_pk_bf16(o1[4 * rq] * rn * g1[0], o1[4 * rq + 1] * rn * g1[1]); w1.y = pg8::cvt_pk_bf16(o1[4 * rq + 2] * rn * g1[2], o1[4 * rq + 3] * rn * g1[3]);
        *(LAS u32x2*)(stg + r32 * 144 + d0 * 2) = w0; *(LAS u32x2*)(stg + r32 * 144 + (32 + d0) * 2) = w1;
    }
    LDS_WAIT();
    bf16_t* ob = outp + (tokq - r32) * 1024;
#pragma unroll
    for (int i = 0; i < 4; ++i) { const int row = i * 8 + (lane >> 3), ch = lane & 7;
        const u32x4 v = *(const LAS u32x4*)(stg + row * 144 + ch * 16);
        *(u32x4*)(ob + (size_t)row * 1024 + ch * 8) = v; }
    LDS_WAIT();
}
}

#define XB_TMO      128
#define XB_XCNT(j)  (256  + 64 * (j))
#define XB_XSUB(j)  (1280 + 64 * (j))
#define XB_XGEN(j)  (2304 + 64 * (j))
#define XB_TOP      3328
#define XB_TOPGEN   3392
#define XCD_BAR_WORDS 3456
#define XB_SPIN_CAP (1u << 18)

__device__ __forceinline__ unsigned xb_ld(unsigned* p)              { return __hip_atomic_load(p, __ATOMIC_RELAXED, __HIP_MEMORY_SCOPE_AGENT); }
__device__ __forceinline__ unsigned xb_add(unsigned* p, unsigned v) { return __hip_atomic_fetch_add(p, v, __ATOMIC_RELAXED, __HIP_MEMORY_SCOPE_AGENT); }
__device__ __forceinline__ unsigned xb_xcc_id() { return (unsigned)__builtin_amdgcn_s_getreg((3 << 11) | 20) & 0xFu; }
#define XB_SPIN(cond, bar) do { unsigned _sp = 0; while (cond) { __builtin_amdgcn_s_sleep(1); \
    if ((++_sp & 255u) == 0u) { if (xb_ld(&(bar)[XB_TMO])) break; if (_sp > XB_SPIN_CAP) { atomicAdd(&(bar)[XB_TMO], 1u); break; } } } } while (0)

struct XcdBarrier {
    unsigned* bar; unsigned x;
    volatile LAS unsigned* st;
};

__device__ __forceinline__ XcdBarrier xcd_barrier_post(unsigned* bar, volatile LAS unsigned* st) {
    XcdBarrier b; b.bar = bar; b.x = xb_xcc_id(); b.st = st;
    if (threadIdx.x == 0) (void)xb_add(&bar[XB_XCNT(b.x)], 1u);
    return b;
}
__device__ __forceinline__ void xcd_barrier_complete(unsigned* bar, unsigned x, unsigned& nloc, unsigned& nx) {
    const unsigned G = gridDim.x * gridDim.y * gridDim.z;
    unsigned sum, cnt, mine, sp = 0u;
    for (;;) {
        sum = 0u; cnt = 0u; mine = 0u;
#pragma unroll
        for (unsigned j = 0; j < 16; ++j) { const unsigned c = xb_ld(&bar[XB_XCNT(j)]); sum += c; cnt += (c > 0u) ? 1u : 0u; mine = (j == x) ? c : mine; }
        if (sum == G) break;
        __builtin_amdgcn_s_sleep(1);
        if ((++sp & 255u) == 0u) { if (xb_ld(&bar[XB_TMO])) break; if (sp > XB_SPIN_CAP) { atomicAdd(&bar[XB_TMO], 1u); break; } }
    }
    nloc = mine > 0u ? mine : 1u; nx = cnt > 0u ? cnt : 1u;
}

__device__ __forceinline__ void xcd_barrier(const XcdBarrier& b) {
    asm volatile("s_waitcnt vmcnt(0)" ::: "memory");
    __syncthreads();
    if (threadIdx.x == 0) {
        unsigned* bar = b.bar;
        __builtin_amdgcn_s_waitcnt(0);
        unsigned nloc = b.st[0], nx = b.st[1];
        if (nloc == 0u) { xcd_barrier_complete(bar, b.x, nloc, nx); b.st[0] = nloc; b.st[1] = nx; }
        const unsigned old = xb_add(&bar[XB_XSUB(b.x)], 1u);
        const unsigned gen = old / nloc;
        if (old + 1u == (gen + 1u) * nloc) {
            __builtin_amdgcn_fence(__ATOMIC_RELEASE, "agent");
            asm volatile("s_waitcnt vmcnt(0)" ::: "memory");
            const unsigned og = xb_add(&bar[XB_TOP], 1u);
            const unsigned tg = og / nx;
            if (og + 1u == (tg + 1u) * nx) xb_add(&bar[XB_TOPGEN], 1u);
            else XB_SPIN(xb_ld(&bar[XB_TOPGEN]) == tg, bar);
            __builtin_amdgcn_fence(__ATOMIC_ACQUIRE, "agent");
            xb_add(&bar[XB_XGEN(b.x)], 1u);
            asm volatile("s_waitcnt vmcnt(0)" ::: "memory");
        } else {
            XB_SPIN(xb_ld(&bar[XB_XGEN(b.x)]) == gen, bar);
            __builtin_amdgcn_fence(__ATOMIC_ACQUIRE, "agent");
            asm volatile("s_waitcnt vmcnt(0)" ::: "memory");
        }
    }
    __syncthreads();
}

struct Params {
    const float* in[25]; float* out; unsigned char* ws;
    int ph_lo, ph_hi, coop, pad;
    float inv_freq[16];
};
constexpr int NPHASES = 1 + 9 * DEPTH;
constexpr int LDS_BYTES = 131072 + 1024;

__global__ void __launch_bounds__(NTHREADS) fwd_kernel(Params p) {
    extern __shared__ __attribute__((aligned(16))) unsigned char lds_raw[];
    LAS unsigned char* lds = (LAS unsigned char*)lds_raw;
    const int G = gridDim.x, bid = blockIdx.x;
#define PHASE_IDS() int tid = threadIdx.x; asm volatile("" : "+v"(tid)); const int lane = tid & 63, wave = __builtin_amdgcn_readfirstlane(tid >> 6); const int gw = bid * NWAVES + wave; (void)gw; (void)lane
    const int vcu = (G % 8 == 0) ? (bid % 8) * (G / 8) + bid / 8 : bid;
    const int NGW = G * NWAVES;
    unsigned char* ws = p.ws;
    const float* x0 = p.in[0]; const float* cvec = p.in[1]; const int* pos = (const int*)p.in[2];
    float* mod = (float*)(ws + WS_MOD); float* cosT = (float*)(ws + WS_COS); float* sinT = (float*)(ws + WS_SIN);
    bf16_t* H = (bf16_t*)(ws + WS_H); bf16_t* Vb = (bf16_t*)(ws + WS_V); float* SSQ2 = (float*)(ws + WS_SSQ2);
    float* XA = (float*)(ws + WS_XA);
    float* SSQ = (float*)(ws + WS_SSQ); float* BIASIN = (float*)(ws + WS_BIASIN); float* BIASGU = (float*)(ws + WS_BIASGU); float* AVEC = (float*)(ws + WS_AVEC);
    bf16_t* QNA = (bf16_t*)(ws + WS_QNA); bf16_t* KNA = (bf16_t*)(ws + WS_KNA); bf16_t* VNA = (bf16_t*)(ws + WS_VNA);
    bf16_t* P = (bf16_t*)(ws + WS_P); bf16_t* QN = (bf16_t*)(ws + WS_QN); bf16_t* KN = (bf16_t*)(ws + WS_KN); bf16_t* QR = (bf16_t*)(ws + WS_QR);
    bf16_t* KR = (bf16_t*)(ws + WS_KR); bf16_t* MIX = (bf16_t*)(ws + WS_MIX); bf16_t* ACT = (bf16_t*)(ws + WS_ACT);
    cg::grid_group grid = cg::this_grid();
    const int lo = p.ph_lo, hi = p.ph_hi;
#ifndef REP_P0
#define REP_P0 0
#endif
#ifndef REP_MASK
#define REP_MASK 0
#endif
#ifndef PH_MASK
#define PH_MASK 0x3ff
#endif
#define IN_PH(k) (lo <= (k) && (k) < hi)
#define IN_PHL(c) (((PH_MASK >> ((c) + 1)) & 1) && lo <= (pb + (c)) && (pb + (c)) < hi)
#define SEAM(k) do { if (IN_PH(k) && IN_PH((k) + 1)) xcd_barrier(xbar); } while (0)
    LAS unsigned* misc = (LAS unsigned*)(lds + 131072);
    unsigned* barw = (unsigned*)(ws + WS_BAR);
    if (threadIdx.x < 16) misc[threadIdx.x] = 0u;
    if (p.coop && bid == 0) for (int i = threadIdx.x; i < XCD_BAR_WORDS; i += NTHREADS) __hip_atomic_store(barw + i, 0u, __ATOMIC_RELAXED, __HIP_MEMORY_SCOPE_AGENT);
    __syncthreads();
    XcdBarrier xbar; xbar.bar = barw; xbar.x = 0; xbar.st = (volatile LAS unsigned*)misc;

    if ((PH_MASK & 1) && IN_PH(0)) for (int rep0_ = 0; rep0_ <= REP_P0; ++rep0_) {
        PHASE_IDS();
        { LAS float* red = (LAS float*)lds; LAS float* sc = (LAS float*)(lds + 8192);
          for (int i = tid; i < 4 * D; i += NTHREADS) { const float cv = cvec[i]; sc[i] = cv / (1.f + __expf(-cv)); }
          __syncthreads();
          for (int item = bid; item < 2 * NMOD / 64; item += G) {
            const int col = item * 64 + lane, l = col / NMOD, j = col % NMOD;
            const float* wp = p.in[5] + ((size_t)l * D + wave * 128) * NMOD + j;
            const LAS float* scw = sc + wave * 128;
            float a0 = 0.f, a1 = 0.f, a2 = 0.f, a3 = 0.f;
#pragma unroll 1
            for (int k0 = 0; k0 < 128; k0 += 32) { float w[32];
#pragma unroll
                for (int k = 0; k < 32; ++k) w[k] = wp[(size_t)(k0 + k) * NMOD];
#pragma unroll
                for (int k = 0; k < 32; ++k) { a0 += scw[k0 + k] * w[k]; a1 += scw[D + k0 + k] * w[k]; a2 += scw[2 * D + k0 + k] * w[k]; a3 += scw[3 * D + k0 + k] * w[k]; } }
            red[(wave * 4 + 0) * 64 + lane] = a0; red[(wave * 4 + 1) * 64 + lane] = a1; red[(wave * 4 + 2) * 64 + lane] = a2; red[(wave * 4 + 3) * 64 + lane] = a3;
            __syncthreads();
            if (wave < 4) { float s = p.in[6][(size_t)l * NMOD + j];
#pragma unroll
                for (int kc = 0; kc < 8; ++kc) s += red[(kc * 4 + wave) * 64 + lane];
                mod[((size_t)l * 4 + wave) * NMOD + j] = s; }
            __syncthreads();
          } }
        for (int i = bid * NTHREADS + tid; i < 3 * M; i += G * NTHREADS) SSQ[M + i] = 0.f;
        for (int i = bid * NTHREADS + tid; i < 4 * M; i += G * NTHREADS) SSQ2[i] = 0.f;
        for (int i = bid * NTHREADS + tid; i < M * 16; i += G * NTHREADS) {
            const int row = i >> 4, e = i & 15;
            const float ang = (float)pos[row] * p.inv_freq[e];
            double rev = (double)ang * 0.15915494309189535; rev -= rint(rev);
            const float fr = (float)rev;
            cosT[i] = __builtin_amdgcn_cosf(fr); sinT[i] = __builtin_amdgcn_sinf(fr);
        }
        { LAS float* scr = (LAS float*)(lds + wave * 16384);
          constexpr int I0 = (N_IN / 32) * (D / 64), I1 = (N_UQ / 32) * (K_UQ / 64), I2 = (N_UKV / 32) * (K_UKV / 64), I3 = (D / 32) * (D / 64), I4 = (N_GU / 32) * (D / 64), I5 = (D / 32) * (DFF / 64);
          constexpr int IPL = I0 + I1 + I2 + I3 + I4 + I5;
          for (int it = gw; it < DEPTH * IPL; it += NGW) {
            const int l = it / IPL; int r = it % IPL;
            bf16_t* wl = (bf16_t*)(ws + WS_W + (size_t)l * W_LAYER);
            if (r < I0) { transpose_item(p.in[7] + (size_t)l * D * D_IN, D, D_IN, 0, (bf16_t*)((unsigned char*)wl + WO_IN), scr, r, N_IN / 32, lane); continue; } r -= I0;
            if (r < I1) { transpose_item(p.in[13] + (size_t)l * K_UQ * N_UQ, K_UQ, N_UQ, 1, (bf16_t*)((unsigned char*)wl + WO_UQ), scr, r, N_UQ / 32, lane, p.in[11] + (size_t)l * K_UQ); continue; } r -= I1;
            if (r < I2) { transpose_item(p.in[14] + (size_t)l * K_UKV * N_UKV, K_UKV, N_UKV, 2, (bf16_t*)((unsigned char*)wl + WO_UKV), scr, r, N_UKV / 32, lane, p.in[12] + (size_t)l * K_UKV); continue; } r -= I2;
            if (r < I3) { transpose_item(p.in[22] + (size_t)l * D * D, D, D, 3, (bf16_t*)((unsigned char*)wl + WO_OUT), scr, r, D / 32, lane); continue; } r -= I3;
            if (r < I4) { transpose_item(p.in[23] + (size_t)l * D * N_GU, D, N_GU, 4, (bf16_t*)((unsigned char*)wl + WO_GU), scr, r, N_GU / 32, lane); continue; } r -= I4;
            transpose_item(p.in[24] + (size_t)l * DFF * D, DFF, D, 5, (bf16_t*)((unsigned char*)wl + WO_DOWN), scr, r, D / 32, lane);
          } }
    }
    if (p.coop) { grid.sync(); xbar = xcd_barrier_post(barw, (volatile LAS unsigned*)misc); }

    for (int l = 0; l < DEPTH; ++l) {
        const int pb = 1 + 9 * l;
        const float* xin = (l == 0) ? x0 : p.out;
        const float* modl = mod + (size_t)l * 4 * NMOD;
        const unsigned char* wl = ws + WS_W + (size_t)l * W_LAYER;
        if (l == 0) {
        if (IN_PHL(0)) for (int rep_ = 0; rep_ <= ((REP_MASK >> 0) & 1); ++rep_) {
            PHASE_IDS();
            for (int i = bid * NTHREADS + tid; i < 2 * 2 * 4 * D; i += G * NTHREADS) {
                const int k = i & (D - 1), b = (i >> 10) & 3, which = (i >> 12) & 1, l2 = i >> 13;
                AVEC[i] = p.in[3 + which][(size_t)l2 * D + k] * (1.f + mod[((size_t)l2 * 4 + b) * NMOD + (which ? 4 : 1) * D + k]);
            }
            for (int rr = gw; rr < 2 * (N_IN + N_GU); rr += NGW) {
                const int l2 = rr / (N_IN + N_GU), r2 = rr % (N_IN + N_GU); const bool isgu = r2 >= N_IN; const int n = isgu ? r2 - N_IN : r2;
                const bf16_t* wrow = (const bf16_t*)(ws + WS_W + (size_t)l2 * W_LAYER + (isgu ? WO_GU : WO_IN)) + (size_t)n * D + 16 * lane;
                const u32x4 wa = *(const u32x4*)wrow, wb = *(const u32x4*)(wrow + 8);
                float wv[16];
#pragma unroll
                for (int i = 0; i < 4; ++i) { wv[2 * i] = bf_lo(wa[i]); wv[2 * i + 1] = bf_hi(wa[i]); wv[8 + 2 * i] = bf_lo(wb[i]); wv[8 + 2 * i + 1] = bf_hi(wb[i]); }
                float s4[4];
#pragma unroll
                for (int b = 0; b < 4; ++b) { const float* sh = mod + ((size_t)l2 * 4 + b) * NMOD + (isgu ? 3 : 0) * D + 16 * lane; float s = 0.f;
#pragma unroll
                    for (int i = 0; i < 16; ++i) s += sh[i] * wv[i];
                    s4[b] = wave_sum(s); }
                if (lane < 4) { float* bo = isgu ? BIASGU + ((size_t)l2 * 4 + lane) * N_GU + n : BIASIN + ((size_t)l2 * 4 + lane) * N_IN + n;
                    *bo = lane == 0 ? s4[0] : lane == 1 ? s4[1] : lane == 2 ? s4[2] : s4[3]; }
            }
            const float* gn = p.in[3] + (size_t)l * D;
            for (int m0 = gw * 16; m0 < M; m0 += NGW * 16) {
                const int b = m0 / T; const float* mb = modl + (size_t)b * NMOD;
                f32x4 a[4];
#pragma unroll
                for (int j = 0; j < 4; ++j) { const int cc = 4 * lane + 256 * j; a[j] = *(const f32x4*)(gn + cc) * (*(const f32x4*)(mb + D + cc) + 1.f); }
                for (int r = 0; r < 16; ++r) {
                    const f32x4* xr = (const f32x4*)(xin + (size_t)(m0 + r) * D) + lane;
                    f32x4 v[4]; float ss = 0.f;
#pragma unroll
                    for (int j = 0; j < 4; ++j) { v[j] = xr[64 * j]; ss += (v[j][0] * v[j][0] + v[j][1] * v[j][1]) + (v[j][2] * v[j][2] + v[j][3] * v[j][3]); }
                    ss = wave_sum(ss);
                    if (lane == 0) SSQ[m0 + r] = ss;
                    u32x2* o8 = (u32x2*)(H + (size_t)(m0 + r) * D) + lane;
#pragma unroll
                    for (int j = 0; j < 4; ++j) { const f32x4 o = v[j] * a[j]; u32x2 w; w.x = pg8::cvt_pk_bf16(o[0], o[1]); w.y = pg8::cvt_pk_bf16(o[2], o[3]); o8[64 * j] = w; }
                }
            }
        }
        SEAM(pb + 0);
        }
        if (IN_PHL(1)) for (int rep_ = 0; rep_ <= ((REP_MASK >> 1) & 1); ++rep_) {
            pg8::Gemm g{H, (const bf16_t*)(wl + WO_IN), M, N_IN, D, D}; pg8::StaticOrder S; S.init(M, N_IN, G, bid);
            EpiIn E{ws, l, p.in[8] + l * 64, p.in[9] + l * 64, p.in[18] + l * 32, 0.125f * LOG2E};
            pg8::gemm_phase<EpiIn, pg8::StaticOrder, true, true>(lds, g, S, E);
        }
        SEAM(pb + 1);
        if (IN_PHL(3)) for (int rep_ = 0; rep_ <= ((REP_MASK >> 3) & 1); ++rep_) {
            { PHASE_IDS();
              const float* cw = p.in[19] + (size_t)l * 3 * 256; const float* cb = p.in[20] + (size_t)l * 256; const float* ong = p.in[21] + (size_t)l * D + 768;
              const f32x4 w0 = *(const f32x4*)(cw + 4 * lane), w1 = *(const f32x4*)(cw + 256 + 4 * lane), w2 = *(const f32x4*)(cw + 512 + 4 * lane), cbv = *(const f32x4*)(cb + 4 * lane), ogv = *(const f32x4*)(ong + 4 * lane);
              for (int m0 = gw * 16; m0 < M; m0 += NGW * 16) {
#pragma unroll 1
                for (int hb = 0; hb < 2; ++hb) {
                    const int mb0 = m0 + 8 * hb, tb0 = mb0 % T, seq0 = mb0 - tb0;
                    u32x2 xi[10], gc[10], gbu[8];
#pragma unroll
                    for (int i = 0; i < 10; ++i) { const int tt = min(max(tb0 - 1 + i, 0), T - 1); const bf16_t* q = P + (size_t)(seq0 + tt) * 1536;
                        xi[i] = *(const u32x2*)(q + 768 + 4 * lane); gc[i] = *(const u32x2*)(q + 1280 + 4 * lane); }
#pragma unroll
                    for (int r = 0; r < 8; ++r) gbu[r] = *(const u32x2*)(P + (size_t)(mb0 + r) * 1536 + 1024 + 4 * lane);
                    f32x4 uu[10];
#pragma unroll
                    for (int i = 0; i < 10; ++i) { const int tt = tb0 - 1 + i; const float mk = (tt >= 0 && tt < T) ? 1.f : 0.f;
                        uu[i] = (f32x4){bf_lo(xi[i].x) * bf_lo(gc[i].x), bf_hi(xi[i].x) * bf_hi(gc[i].x), bf_lo(xi[i].y) * bf_lo(gc[i].y), bf_hi(xi[i].y) * bf_hi(gc[i].y)} * mk; }
#pragma unroll
                    for (int r = 0; r < 8; ++r) {
                        const f32x4 gb = {bf_lo(gbu[r].x), bf_hi(gbu[r].x), bf_lo(gbu[r].y), bf_hi(gbu[r].y)};
                        const f32x4 y = gb * (w0 * uu[r] + w1 * uu[r + 1] + w2 * uu[r + 2] + cbv);
                        float ss = (y[0] * y[0] + y[1] * y[1]) + (y[2] * y[2] + y[3] * y[3]);
                        ss += __shfl_xor(ss, 1); ss += __shfl_xor(ss, 2); ss += __shfl_xor(ss, 4); ss += __shfl_xor(ss, 8);
                        const float rs = rsqrtf(ss * (1.f / 64.f) + EPS);
                        const f32x4 o = y * rs * ogv;
                        u32x2 w; w.x = pg8::cvt_pk_bf16(o[0], o[1]); w.y = pg8::cvt_pk_bf16(o[2], o[3]);
                        *(u32x2*)(MIX + (size_t)(mb0 + r) * D + 768 + 4 * lane) = w;
                    }
                }
              } }
#pragma unroll 1
            for (int which = 0; which < 2; ++which) {
                pg8::Gemm g{which ? P + 512 : P, (const bf16_t*)(wl + (which ? WO_UKV : WO_UQ)), M, which ? N_UKV : N_UQ, which ? K_UKV : K_UQ, 1536};
                pg8::StaticOrder S; S.init(M, g.N, G, bid);
                EpiHeads E{which ? KN : QN, which ? Vb : QR, which ? p.in[16] + l * 64 : p.in[15] + l * 64, SSQ2 + (size_t)(2 * l + which) * M,
                           which ? 1.f : 0.10206207261596575f * LOG2E, which ? 1.f / K_UKV : 1.f / K_UQ, which ? 512 : 256, 0};
                pg8::gemm_phase<EpiHeads, pg8::StaticOrder, true, true>(lds, g, S, E);
            }
        }
        SEAM(pb + 3);
        if (IN_PHL(4)) for (int rep_ = 0; rep_ <= ((REP_MASK >> 4) & 1); ++rep_) {
            const float* ong = p.in[21] + (size_t)l * D;
            for (int ui = vcu; ui < BATCH * 8 * 32; ui += G) {
                const int bh = ui >> 5, qb = ui & 31, b = bh >> 3, h = bh & 7;
                att::attn_unit<false>(lds, b, h, qb, QN, 512, QR, KN, 512, KR, Vb, 512, nullptr, ong + 256 + h * 64, MIX + 256 + h * 64, cosT, sinT, p.in[17] + l * 32, 0.10206207261596575f * LOG2E, p.in[16] + l * 64, p.in[18] + l * 32);
            }
            for (int ui = vcu; ui < BATCH * 4 * 32; ui += G) {
                const int bh = ui >> 5, gq = ui & 31, b = bh >> 2, h = bh & 3;
                att::attn_unit<true>(lds, b, h, gq, QNA, 256, nullptr, KNA, 256, nullptr, VNA, 256, p.in[10] + ((size_t)l * 4 + h) * 15 * 31, ong + h * 64, MIX + h * 64, nullptr, nullptr, nullptr, 0.f, p.in[9] + l * 64, nullptr);
            }
        }
        SEAM(pb + 4);
        if (IN_PHL(5)) for (int rep_ = 0; rep_ <= ((REP_MASK >> 5) & 1); ++rep_) {
            pg8::Gemm g{MIX, (const bf16_t*)(wl + WO_OUT), M, D, D, D}; pg8::StaticOrder S; S.init(M, D, G, bid);
            EpiRes E{xin, XA, modl + 2 * D, H, AVEC + (size_t)(2 * l + 1) * 4 * D, SSQ + (size_t)(2 * l + 1) * M};
            pg8::gemm_phase<EpiRes, pg8::StaticOrder, true, true>(lds, g, S, E);
        }
        SEAM(pb + 5);
        if (IN_PHL(7)) for (int rep_ = 0; rep_ <= ((REP_MASK >> 7) & 1); ++rep_) {
            pg8::Gemm g{H, (const bf16_t*)(wl + WO_GU), M, N_GU, D, D}; pg8::StaticOrder S; S.init(M, N_GU, G, bid);
            EpiGU E{ACT, SSQ + (size_t)(2 * l + 1) * M, BIASGU + (size_t)l * 4 * N_GU};
            pg8::gemm_phase<EpiGU, pg8::StaticOrder, false, true>(lds, g, S, E);
        }
        SEAM(pb + 7);
        if (IN_PHL(8)) for (int rep_ = 0; rep_ <= ((REP_MASK >> 8) & 1); ++rep_) {
            pg8::Gemm g{ACT, (const bf16_t*)(wl + WO_DOWN), M, D, DFF, DFF}; pg8::StaticOrder S; S.init(M, D, G, bid);
            EpiRes E{XA, p.out, modl + 5 * D, (l + 1 < DEPTH) ? H : nullptr, AVEC + (size_t)(2 * (l + 1)) * 4 * D, SSQ + (size_t)(2 * (l + 1)) * M};
            pg8::gemm_phase<EpiRes, pg8::StaticOrder, true, true>(lds, g, S, E);
        }
        SEAM(pb + 8);
    }
#undef IN_PH
#undef IN_PHL
#undef SEAM
}

#ifndef N_LAUNCH_MODE
#define N_LAUNCH_MODE 1
#endif
extern "C" void kernel_launch(void* const* d_in, const int* in_sizes, int n_in, void* d_out, int out_size, void* d_ws, size_t ws_size, hipStream_t stream) {
    static int grid = 0;
    if (grid == 0) {
        if (n_in != 25 || out_size != M * D || ws_size < WS_END) { fprintf(stderr, "kernel_launch: unexpected shapes (n_in %d out %d ws %zu)\n", n_in, out_size, ws_size); grid = -1; return; }
        int dev = 0, cus = 0, per_cu = 0;
        hipGetDevice(&dev); hipDeviceGetAttribute(&cus, hipDeviceAttributeMultiprocessorCount, dev);
        if (hipFuncSetAttribute((const void*)fwd_kernel, hipFuncAttributeMaxDynamicSharedMemorySize, LDS_BYTES) != hipSuccess) { fprintf(stderr, "kernel_launch: hipFuncSetAttribute failed\n"); grid = -1; return; }
        if (hipOccupancyMaxActiveBlocksPerMultiprocessor(&per_cu, (const void*)fwd_kernel, NTHREADS, LDS_BYTES) != hipSuccess || per_cu < 1) { fprintf(stderr, "kernel_launch: occupancy query says %d\n", per_cu); per_cu = 1; }
        (void)hipGetLastError();
        grid = cus;
    }
    if (grid < 0) return;
    Params p{};
    for (int i = 0; i < 25; ++i) p.in[i] = (const float*)d_in[i];
    p.out = (float*)d_out; p.ws = (unsigned char*)d_ws;
    for (int e = 0; e < 16; ++e) p.inv_freq[e] = (float)pow(10000.0, -(double)(2 * e) / 32.0);
#if N_LAUNCH_MODE == 1
    p.ph_lo = 0; p.ph_hi = NPHASES; p.coop = 1;
    void* args[] = {&p};
    hipError_t e = hipLaunchCooperativeKernel((const void*)fwd_kernel, dim3(grid), dim3(NTHREADS), args, LDS_BYTES, stream);
    if (e != hipSuccess) fprintf(stderr, "cooperative launch failed: %s (grid %d)\n", hipGetErrorString(e), grid);
#else
    for (int ph = 0; ph < NPHASES; ++ph) {
        p.ph_lo = ph; p.ph_hi = ph + 1; p.coop = 0;
        hipLaunchKernelGGL(fwd_kernel, dim3(grid), dim3(NTHREADS), LDS_BYTES, stream, p);
    }
#endif
}
```

```cpp
#include <hip/hip_runtime.h>
#include <hip/hip_cooperative_groups.h>
#include <cstdio>
#include <cstdint>
#include <cmath>
namespace cg = cooperative_groups;
namespace pg8 {
#define PG8_LAS __attribute__((address_space(3)))
typedef unsigned short bf16_t;
typedef short bf16x8 __attribute__((ext_vector_type(8)));
typedef float f32x4 __attribute__((ext_vector_type(4)));
typedef unsigned u32x4 __attribute__((ext_vector_type(4)));
constexpr int BM = 256, BK = 64, HALF = 128, HTB = HALF * BK * 2  , STAGE_BYTES = 8 * HTB, NXCD = 8, WGM = 8;

__host__ __device__ __forceinline__ int lds_byte(int r, int c) { const int st = (r >> 4) * 2 + (c >> 5), rr = r & 15, cc = c & 31, ob = rr * 64 + cc * 2; return st * 1024 + (ob ^ (((ob >> 9) & 1) << 5)); }
__host__ __device__ __forceinline__ void stage_rc(int b, int& R, int& C) { const int st = b / 1024, sb = b % 1024, swz = sb ^ (((sb >> 9) & 1) << 5); R = (st >> 1) * 16 + swz / 64; C = (st & 1) * 32 + (swz % 64) / 2; }
__host__ __device__ __forceinline__ int perm32(int rho) { const int n = rho >> 4, i = rho & 15; return 8 * (i >> 2) + 4 * n + (i & 3); }

struct Unit { int pm, pn; };
struct Gemm { const bf16_t* A; const bf16_t* Bt; int M, N, K, lda; };

struct StaticOrder {
    int nM, nN, nwg, G, c;
    __host__ __device__ void init(int M, int N, int G_, int c_) { nM = M / BM; nN = N / BM; nwg = nM * nN; G = G_; c = c_; }
    __host__ __device__ bool next(int i, Unit& u) const {
        const long L = (long)i * G + c; if (L >= nwg) return false;
        int wgid = (int)L; { const int q = nwg / NXCD, r = nwg % NXCD, xcd = wgid % NXCD, off = wgid / NXCD; wgid = (xcd < r ? xcd * (q + 1) : r * (q + 1) + (xcd - r) * q) + off; }
        const int nig = WGM * nN, gid = wgid / nig, fm = gid * WGM, gsz = (nM - fm) < WGM ? (nM - fm) : WGM;
        u.pm = fm + ((wgid % nig) % gsz); u.pn = (wgid % nig) / gsz; return true;
    }
    __device__ __forceinline__ void a_ready(const Unit&) const {}
    __device__ __forceinline__ void done(const Unit&) const {}
};
__device__ __forceinline__ unsigned cvt_pk_bf16(float lo, float hi) { unsigned r; asm volatile("v_cvt_pk_bf16_f32 %0, %1, %2" : "=v"(r) : "v"(lo), "v"(hi)); return r; }
template <class Epi, class Sched, bool ALIGN_EPI = false, bool SP2 = false>
__device__ __forceinline__ void gemm_phase(PG8_LAS unsigned char* lds, const Gemm g, const Sched& S, const Epi& E) {
    int tid_ = threadIdx.x; asm volatile("" : "+v"(tid_));
    const int tid = tid_, wid = __builtin_amdgcn_readfirstlane(tid >> 6), lane = tid & 63, wr = wid >> 2, wc = wid & 3, fr = lane & 15, fq = lane >> 4;
    const int K = g.K, nt = K / BK;
    unsigned voffA[2], voffB[2];
#pragma unroll
    for (int i = 0; i < 2; ++i) { int R, C; stage_rc(tid * 16 + i * 8192, R, C); const int Rb = Epi::PERM ? ((R & ~31) + perm32(R & 31)) : R;
        voffA[i] = (unsigned)(R * g.lda + C) * 2u; voffB[i] = (unsigned)(Rb * K + C) * 2u; }
    const size_t kstep = (size_t)(BK * 2);
    const size_t hstep = (size_t)HALF * K * 2;
    const size_t tstep = 2 * hstep; const size_t hstepA = (size_t)HALF * g.lda * 2, tstepA = 2 * hstepA;
    const unsigned ldsw = (unsigned)wid * 1024u;
    const int aoff = lds_byte(wr * 64 + fr, fq * 8), boff = lds_byte(wc * 32 + fr, fq * 8);
#define PG8_SA(b, h) (((b) * 2 + (h)) * HTB)
#define PG8_SB(b, h) ((4 + (b) * 2 + (h)) * HTB)
#define PG8_STAGE(bufoff, gbase, voff) do { _Pragma("unroll") for (int _i = 0; _i < 2; ++_i) \
        __builtin_amdgcn_global_load_lds((const unsigned*)((const char*)(gbase) + (voff)[_i]), (PG8_LAS unsigned*)(lds + (bufoff) + ldsw + _i * 8192), 16, 0, 0); } while (0)
#define PG8_LDA(dst, b, h) do { _Pragma("unroll") for (int m = 0; m < 4; ++m) _Pragma("unroll") for (int k = 0; k < 2; ++k) dst[m][k] = *(const PG8_LAS bf16x8*)(lds + PG8_SA(b, h) + aoff + m * 2048 + k * 1024); } while (0)
#define PG8_LDB(dst, b, h) do { _Pragma("unroll") for (int n = 0; n < 2; ++n) _Pragma("unroll") for (int k = 0; k < 2; ++k) dst[n][k] = *(const PG8_LAS bf16x8*)(lds + PG8_SB(b, h) + boff + n * 2048 + k * 1024); } while (0)
#define PG8_MMA(ai, bj, At, Bt) do { __builtin_amdgcn_s_setprio(1); _Pragma("unroll") for (int m = 0; m < 4; ++m) _Pragma("unroll") for (int n = 0; n < 2; ++n) _Pragma("unroll") for (int k = 0; k < 2; ++k) \
        acc[ai][bj][m][n] = __builtin_amdgcn_mfma_f32_16x16x32_bf16(Bt[n][k], At[m][k], acc[ai][bj][m][n], 0, 0, 0); __builtin_amdgcn_s_setprio(0); } while (0)
#define PG8_WAIT_V(n) asm volatile("s_waitcnt vmcnt(" #n ")" ::: "memory")
#define PG8_WAIT_L(n) asm volatile("s_waitcnt lgkmcnt(" #n ")" ::: "memory")
#define PG8_BAR __builtin_amdgcn_s_barrier()
#define PG8_SCHED __builtin_amdgcn_sched_barrier(0)
    Unit cur, nxt; int ui = 0;
    if (!S.next(0, cur)) return;
    f32x4 acc[2][2][4][2];
#pragma unroll
    for (int a = 0; a < 2; ++a)
#pragma unroll
        for (int b = 0; b < 2; ++b)
#pragma unroll
            for (int m = 0; m < 4; ++m)
#pragma unroll
                for (int n = 0; n < 2; ++n) acc[a][b][m][n] = (f32x4){0.f, 0.f, 0.f, 0.f};
    bf16x8 At[4][2], B0[2][2], B1[2][2];
    const char* cA = (const char*)g.A + (size_t)cur.pm * tstepA; const char* cB = (const char*)g.Bt + (size_t)cur.pn * tstep;
    S.a_ready(cur);
    if constexpr (SP2) {
        PG8_STAGE(PG8_SB(0, 0), cB, voffB); PG8_STAGE(PG8_SB(0, 1), cB + hstep, voffB); PG8_STAGE(PG8_SA(0, 0), cA, voffA); PG8_STAGE(PG8_SA(0, 1), cA + hstepA, voffA);
        if (wr == 1) PG8_BAR;
        PG8_WAIT_V(2); PG8_BAR;
        PG8_STAGE(PG8_SB(1, 0), cB + kstep, voffB); PG8_STAGE(PG8_SA(1, 0), cA + kstep, voffA); PG8_STAGE(PG8_SB(1, 1), cB + hstep + kstep, voffB);
        PG8_WAIT_V(6); PG8_BAR;
    } else {
        PG8_STAGE(PG8_SB(0, 0), cB, voffB); PG8_STAGE(PG8_SA(0, 0), cA, voffA); PG8_STAGE(PG8_SB(0, 1), cB + hstep, voffB); PG8_STAGE(PG8_SA(0, 1), cA + hstepA, voffA);
        if (wr == 1) PG8_BAR;
        PG8_WAIT_V(4); PG8_BAR;
        PG8_STAGE(PG8_SB(1, 0), cB + kstep, voffB); PG8_STAGE(PG8_SA(1, 0), cA + kstep, voffA); PG8_STAGE(PG8_SB(1, 1), cB + hstep + kstep, voffB);
        PG8_WAIT_V(6); PG8_BAR;
    }
    for (;;) {
        const bool has_next = S.next(ui + 1, nxt);
        const char* nA = has_next ? (const char*)g.A + (size_t)nxt.pm * tstepA : cA; const char* nB = has_next ? (const char*)g.Bt + (size_t)nxt.pn * tstep : cB;
        for (int t = 0; t < nt; t += 2) {
            const bool last = (t == nt - 2);
            const char* a1 = cA + (size_t)(t + 1) * kstep;
            const char* a2 = last ? nA : cA + (size_t)(t + 2) * kstep; const char* b2 = last ? nB : cB + (size_t)(t + 2) * kstep;
            const char* a3 = a2 + kstep; const char* b3 = b2 + kstep;
            if (last && has_next) S.a_ready(nxt);
            if constexpr (SP2) {
            PG8_LDB(B0, 0, 0); PG8_LDB(B1, 0, 1); PG8_SCHED; PG8_LDA(At, 0, 0); PG8_STAGE(PG8_SA(1, 1), a1 + hstepA, voffA);
            PG8_WAIT_V(8); PG8_WAIT_L(0); PG8_BAR; PG8_MMA(0, 0, At, B0); PG8_MMA(0, 1, At, B1); PG8_BAR; PG8_SCHED;
            PG8_LDA(At, 0, 1); PG8_STAGE(PG8_SB(0, 0), b2, voffB); PG8_STAGE(PG8_SB(0, 1), b2 + hstep, voffB); PG8_STAGE(PG8_SA(0, 0), a2, voffA);
            PG8_WAIT_V(8); PG8_WAIT_L(0); PG8_BAR; PG8_MMA(1, 0, At, B0); PG8_MMA(1, 1, At, B1); PG8_BAR; PG8_SCHED;
            PG8_LDB(B0, 1, 0); PG8_LDB(B1, 1, 1); PG8_SCHED; PG8_LDA(At, 1, 0); PG8_STAGE(PG8_SA(0, 1), a2 + hstepA, voffA);
            PG8_WAIT_V(8); PG8_WAIT_L(0); PG8_BAR; PG8_MMA(0, 0, At, B0); PG8_MMA(0, 1, At, B1); PG8_BAR; PG8_SCHED;
            PG8_LDA(At, 1, 1); PG8_STAGE(PG8_SB(1, 0), b3, voffB); PG8_STAGE(PG8_SB(1, 1), b3 + hstep, voffB); PG8_STAGE(PG8_SA(1, 0), a3, voffA);
            PG8_WAIT_V(8); PG8_WAIT_L(0); PG8_BAR; PG8_MMA(1, 0, At, B0); PG8_MMA(1, 1, At, B1); PG8_BAR; PG8_SCHED;
            } else {
            PG8_LDB(B0, 0, 0); PG8_SCHED; PG8_LDA(At, 0, 0); PG8_STAGE(PG8_SA(1, 1), a1 + hstepA, voffA);
            PG8_WAIT_L(8); PG8_BAR; PG8_WAIT_L(0); PG8_MMA(0, 0, At, B0); PG8_BAR; PG8_SCHED;
            PG8_LDB(B1, 0, 1); PG8_STAGE(PG8_SB(0, 0), b2, voffB);
            PG8_BAR; PG8_WAIT_L(0); PG8_MMA(0, 1, At, B1); PG8_BAR;
            PG8_LDA(At, 0, 1); PG8_STAGE(PG8_SA(0, 0), a2, voffA);
            PG8_BAR; PG8_WAIT_L(0); PG8_MMA(1, 0, At, B0); PG8_BAR; PG8_SCHED;
            PG8_STAGE(PG8_SB(0, 1), b2 + hstep, voffB);
            PG8_WAIT_V(6); PG8_BAR; PG8_MMA(1, 1, At, B1); PG8_BAR;
            PG8_LDB(B0, 1, 0); PG8_SCHED; PG8_LDA(At, 1, 0); PG8_STAGE(PG8_SA(0, 1), a2 + hstepA, voffA);
            PG8_WAIT_L(8); PG8_BAR; PG8_WAIT_L(0); PG8_MMA(0, 0, At, B0); PG8_BAR; PG8_SCHED;
            PG8_LDB(B1, 1, 1); PG8_STAGE(PG8_SB(1, 0), b3, voffB);
            PG8_BAR; PG8_WAIT_L(0); PG8_MMA(0, 1, At, B1); PG8_BAR;
            PG8_LDA(At, 1, 1); PG8_STAGE(PG8_SA(1, 0), a3, voffA);
            PG8_BAR; PG8_WAIT_L(0); PG8_MMA(1, 0, At, B0); PG8_BAR; PG8_SCHED;
            PG8_STAGE(PG8_SB(1, 1), b3 + hstep, voffB);
            PG8_WAIT_V(6); PG8_BAR; PG8_MMA(1, 1, At, B1); PG8_BAR;
            }
        }
        if constexpr (ALIGN_EPI) { if (wr == 0) PG8_BAR; }
        if constexpr (!Epi::AFTER_DRAIN) { E(acc, cur, wr, wc, fr, fq); S.done(cur); }
        if (!has_next) break;
#pragma unroll
        for (int a = 0; a < 2; ++a)
#pragma unroll
            for (int b = 0; b < 2; ++b)
#pragma unroll
                for (int m = 0; m < 4; ++m)
#pragma unroll
                    for (int n = 0; n < 2; ++n) acc[a][b][m][n] = (f32x4){0.f, 0.f, 0.f, 0.f};
        cur = nxt; cA = nA; cB = nB; ++ui;
        if constexpr (ALIGN_EPI) { if (wr == 1) PG8_BAR; }
    }
    PG8_WAIT_V(0);
    if constexpr (!ALIGN_EPI) { if (wr == 0) PG8_BAR; }
    PG8_BAR;
    if constexpr (Epi::AFTER_DRAIN) { E.fused(acc, cur, wr, wc, fr, fq, lds, wid, lane); S.done(cur); }
#undef PG8_SA
#undef PG8_SB
#undef PG8_STAGE
#undef PG8_LDA
#undef PG8_LDB
#undef PG8_MMA
#undef PG8_WAIT_V
#undef PG8_WAIT_L
#undef PG8_BAR
#undef PG8_SCHED
}
}

constexpr int BATCH = 4, T = 8192, D = 1024, M = BATCH * T, DEPTH = 2;
constexpr int D_IN = 2208, DFF = 2816, NMOD = 6 * D;
constexpr int N_IN = 2304, N_UQ = 768, K_UQ = 384, N_UKV = 1024, K_UKV = 256, N_GU = 5632;
constexpr float EPS = 1e-6f, LOG2E = 1.4426950408889634f;
constexpr int NWAVES = 8, NTHREADS = 512;

#define LAS __attribute__((address_space(3)))
typedef unsigned short bf16_t;
typedef float f32x4 __attribute__((ext_vector_type(4)));
typedef unsigned u32x4 __attribute__((ext_vector_type(4)));
typedef unsigned u32x2 __attribute__((ext_vector_type(2)));

constexpr size_t MiB = 1u << 20;
constexpr size_t WS_MOD = 0;
constexpr size_t WS_BAR = 512 * 1024;
constexpr size_t WS_COS = 1 * MiB, WS_SIN = 3 * MiB;
constexpr size_t WS_SSQ = 5 * MiB;
constexpr size_t WS_BIASIN = 5 * MiB + 512 * 1024, WS_BIASGU = WS_BIASIN + 2 * 4 * 2304 * 4;
constexpr size_t WS_AVEC = 5 * MiB + 832 * 1024;
constexpr size_t WS_W = 6 * MiB, W_LAYER = 26 * MiB;
constexpr size_t WO_IN = 0, WO_UQ = 4 * MiB + 512 * 1024, WO_UKV = 5 * MiB + 256 * 1024, WO_OUT = 6 * MiB, WO_GU = 8 * MiB, WO_DOWN = 19 * MiB;
constexpr size_t WS_H = 58 * MiB;
constexpr size_t WS_XA = 122 * MiB;
constexpr size_t WS_QNA = 250 * MiB, WS_KNA = 266 * MiB, WS_VNA = 282 * MiB;
constexpr size_t WS_P = 298 * MiB;
constexpr size_t WS_QN = 122 * MiB, WS_KN = 154 * MiB, WS_QR = 186 * MiB, WS_V = 202 * MiB, WS_KR = 234 * MiB;
constexpr size_t WS_MIX = 412 * MiB, WS_SSQ2 = 476 * MiB, WS_END = 477 * MiB;
constexpr size_t WS_ACT = 250 * MiB;

__device__ __forceinline__ unsigned f2bf(float f) { unsigned u = __builtin_bit_cast(unsigned, f); return (u + 0x7fffu + ((u >> 16) & 1u)) >> 16; }
__device__ __forceinline__ unsigned pk2(float lo, float hi) { return f2bf(lo) | (f2bf(hi) << 16); }
__device__ __forceinline__ float bf_lo(unsigned u) { return __builtin_bit_cast(float, u << 16); }
__device__ __forceinline__ float bf_hi(unsigned u) { return __builtin_bit_cast(float, u & 0xffff0000u); }
__device__ __forceinline__ float wave_sum(float v) {
#pragma unroll
    for (int o = 1; o < 64; o <<= 1) v += __shfl_xor(v, o);
    return v;
}
#define LDS_WAIT() asm volatile("s_waitcnt lgkmcnt(0)" ::: "memory")
template <int CTRL> __device__ __forceinline__ float dpp_xmax(float x) { return fmaxf(x, __int_as_float(__builtin_amdgcn_update_dpp(__float_as_int(x), __float_as_int(x), CTRL, 0xf, 0xf, false))); }
__device__ __forceinline__ float wave_max(float x) {
    x = dpp_xmax<0xB1>(x); x = dpp_xmax<0x4E>(x); x = dpp_xmax<0x141>(x); x = dpp_xmax<0x140>(x);
    auto a = __builtin_amdgcn_permlane16_swap(__float_as_uint(x), __float_as_uint(x), false, false); x = fmaxf(__uint_as_float(a[0]), __uint_as_float(a[1]));
    auto b = __builtin_amdgcn_permlane32_swap(__float_as_uint(x), __float_as_uint(x), false, false); return fmaxf(__uint_as_float(b[0]), __uint_as_float(b[1]));
}
__device__ __forceinline__ float sum_fq(float x) {
    auto a = __builtin_amdgcn_permlane16_swap(__float_as_uint(x), __float_as_uint(x), false, false); x = __uint_as_float(a[0]) + __uint_as_float(a[1]);
    auto b = __builtin_amdgcn_permlane32_swap(__float_as_uint(x), __float_as_uint(x), false, false); return __uint_as_float(b[0]) + __uint_as_float(b[1]);
}

__device__ __forceinline__ int src_col(int id, int c) {
    const int pn = c >> 8, r = c & 255, bj = r >> 7, wc = (r >> 5) & 3, jj = r & 31, lc = 64 * wc + 32 * bj + jj;
    switch (id) {
    case 0:
        if (pn < 3) return 256 * pn + lc;
        if (pn == 3) return 768 + lc;
        if (pn == 4) return lc < 128 ? 1024 + lc : (lc < 160 ? 1408 + (lc - 128) : -1);
        if (pn == 5) return 1152 + lc;
        return 1440 + 256 * (pn - 6) + lc;
    case 1:
        if (pn < 2) return (4 * pn + wc) * 96 + 32 * bj + jj;
        return (2 * wc + bj) * 96 + 64 + jj;
    case 2:
        if (pn < 2) return (4 * pn + wc) * 128 + 32 * bj + jj;
        return (4 * (pn - 2) + wc) * 128 + 64 + 32 * bj + jj;
    case 3: return 256 * pn + lc;
    case 4: return 128 * pn + 32 * wc + jj + (bj ? DFF : 0);
    default: return 256 * pn + lc;
    }
}
__device__ __forceinline__ void transpose_item(const float* __restrict__ W, int K, int Nsrc, int id, bf16_t* __restrict__ WT, LAS float* scr, int item, int nblk, int lane, const float* __restrict__ kgain = nullptr) {
    const int kb = item / nblk, nb = item % nblk, k0 = 64 * kb, n0 = 32 * nb;
    const int sc = src_col(id, n0 + (lane & 31));
    { const float* wp = W + (size_t)(k0 + (lane >> 5)) * Nsrc + (sc >= 0 ? sc : 0);
      float v[32];
#pragma unroll
      for (int i = 0; i < 32; ++i) v[i] = wp[(size_t)(2 * i) * Nsrc];
#pragma unroll
      for (int i = 0; i < 32; ++i) scr[(2 * i + (lane >> 5)) * 33 + (lane & 31)] = sc >= 0 ? v[i] * (kgain ? kgain[k0 + 2 * i + (lane >> 5)] : 1.f) : 0.f; }
    LDS_WAIT();
    const int c = lane & 7;
#pragma unroll
    for (int j = 0; j < 4; ++j) { const int n = (lane >> 3) + 8 * j; const LAS float* s = scr + (8 * c) * 33 + n;
        u32x4 o; o.x = pg8::cvt_pk_bf16(s[0 * 33], s[1 * 33]); o.y = pg8::cvt_pk_bf16(s[2 * 33], s[3 * 33]); o.z = pg8::cvt_pk_bf16(s[4 * 33], s[5 * 33]); o.w = pg8::cvt_pk_bf16(s[6 * 33], s[7 * 33]);
        *(u32x4*)(WT + (size_t)(n0 + n) * K + k0 + 8 * c) = o; }
    LDS_WAIT();
}

__device__ __forceinline__ float other_half(float x) { auto r = __builtin_amdgcn_permlane32_swap(__float_as_uint(x), __float_as_uint(x), false, false);
    return __uint_as_float((threadIdx.x & 32) ? r[0] : r[1]); }
__device__ __forceinline__ void epi_store_heads(const f32x4 (&acc)[2][2][4][2], int row0, int fq, bool norm, const float* __restrict__ g, float scl, bf16_t* __restrict__ dst, int ld, const float* __restrict__ rssq = nullptr, float invk = 0.f) {
#pragma unroll
    for (int ai = 0; ai < 2; ++ai)
#pragma unroll
        for (int m = 0; m < 4; ++m) {
            float r = 1.f, rl = 1.f;
            if (rssq) rl = rsqrtf(rssq[row0 + ai * 128 + m * 16] * invk + EPS);
            if (norm) { float ss = 0.f;
#pragma unroll
                for (int bj = 0; bj < 2; ++bj)
#pragma unroll
                    for (int n = 0; n < 2; ++n) { const f32x4 v = acc[ai][bj][m][n]; ss += (v[0] * v[0] + v[1] * v[1]) + (v[2] * v[2] + v[3] * v[3]); }
                ss = sum_fq(ss);
                r = rsqrtf(ss * rl * rl * (1.f / 64.f) + EPS) * scl; }
            r *= rl;
            bf16_t* rowp = dst + (size_t)(row0 + ai * 128 + m * 16) * ld + 8 * fq;
#pragma unroll
            for (int bj = 0; bj < 2; ++bj) {
                f32x4 g0 = {1.f, 1.f, 1.f, 1.f}, g1 = g0;
                if (norm) { g0 = *(const f32x4*)(g + 32 * bj + 8 * fq); g1 = *(const f32x4*)(g + 32 * bj + 8 * fq + 4); }
                const f32x4 v0 = acc[ai][bj][m][0] * r * g0, v1 = acc[ai][bj][m][1] * r * g1;
                u32x4 w; w.x = pg8::cvt_pk_bf16(v0[0], v0[1]); w.y = pg8::cvt_pk_bf16(v0[2], v0[3]); w.z = pg8::cvt_pk_bf16(v1[0], v1[1]); w.w = pg8::cvt_pk_bf16(v1[2], v1[3]);
                *(u32x4*)(rowp + 32 * bj) = w; }
        }
}
__device__ __forceinline__ void epi_apply_norm(f32x4 (&acc)[2][2][4][2], int row0, int gcol0  , const float* __restrict__ ssq, const float* __restrict__ bias) {
    f32x4 bv[2][2];
#pragma unroll
    for (int bj = 0; bj < 2; ++bj)
#pragma unroll
        for (int n = 0; n < 2; ++n) bv[bj][n] = *(const f32x4*)(bias + gcol0 + 128 * bj + 4 * n);
#pragma unroll
    for (int ai = 0; ai < 2; ++ai)
#pragma unroll
        for (int m = 0; m < 4; ++m) { const float rs = rsqrtf(ssq[row0 + ai * 128 + m * 16] * (1.f / D) + EPS);
#pragma unroll
            for (int bj = 0; bj < 2; ++bj)
#pragma unroll
                for (int n = 0; n < 2; ++n) acc[ai][bj][m][n] = acc[ai][bj][m][n] * rs + bv[bj][n]; }
}
struct EpiIn {
    static constexpr bool PERM = true, AFTER_DRAIN = false;
    unsigned char* ws; int l; const float *qg, *kg, *krg; float qscale;
    __device__ __forceinline__ void operator()(f32x4 (&acc)[2][2][4][2], const pg8::Unit& u, int wr, int wc, int fr, int fq) const {
        const int row0 = u.pm * 256 + wr * 64 + fr;
        bf16_t* qna = (bf16_t*)(ws + WS_QNA); bf16_t* kna = (bf16_t*)(ws + WS_KNA); bf16_t* vna = (bf16_t*)(ws + WS_VNA); bf16_t* P = (bf16_t*)(ws + WS_P); bf16_t* KR = (bf16_t*)(ws + WS_KR);
        const float* ssq = (const float*)(ws + WS_SSQ) + (size_t)(2 * l) * M; const float* bias = (const float*)(ws + WS_BIASIN) + (size_t)l * 4 * N_IN;
        float* ssq_cq = (float*)(ws + WS_SSQ2) + (size_t)(2 * l) * M; float* ssq_ckv = ssq_cq + M;
        const float* cosT = (const float*)(ws + WS_COS); const float* sinT = (const float*)(ws + WS_SIN);
        epi_apply_norm(acc, row0, u.pn * 256 + wc * 32 + fq * 8, ssq, bias + (size_t)(u.pm >> 5) * N_IN);
        bf16_t* dst; int ld = 256; bool norm = false; const float* g = qg; float scl = 1.f;
        if (u.pn == 0) { dst = qna + wc * 64; norm = true; scl = qscale; }
        else if (u.pn == 1) { dst = kna + wc * 64; norm = true; g = kg; }
        else if (u.pn == 2) { dst = vna + wc * 64; }
        else { dst = P + (u.pn - 3) * 256 + wc * 64; ld = 1536; }
        epi_store_heads(acc, row0, fq, norm, g, scl, dst, ld);
        if (u.pn >= 3 && u.pn <= 5) {
            const bool is_cq = (u.pn == 3) || (u.pn == 4 && wc < 2);
            if (is_cq || u.pn == 5) {
                float* sd = is_cq ? ssq_cq : ssq_ckv;
#pragma unroll
                for (int ai = 0; ai < 2; ++ai)
#pragma unroll
                    for (int m = 0; m < 4; ++m) { float ss = 0.f;
#pragma unroll
                        for (int bj = 0; bj < 2; ++bj)
#pragma unroll
                            for (int n = 0; n < 2; ++n) { const f32x4 v = acc[ai][bj][m][n]; ss += (v[0] * v[0] + v[1] * v[1]) + (v[2] * v[2] + v[3] * v[3]); }
                        ss = sum_fq(ss);
                        if (fq == 0) atomicAdd(sd + row0 + ai * 128 + m * 16, ss); }
            } else if (wc == 2) {
                const f32x4 ga = *(const f32x4*)(krg + 8 * fq), gb = *(const f32x4*)(krg + 8 * fq + 4);
#pragma unroll
                for (int ai = 0; ai < 2; ++ai)
#pragma unroll
                    for (int m = 0; m < 4; ++m) { const size_t row = (size_t)(row0 + ai * 128 + m * 16);
                        const f32x4 x0 = acc[ai][0][m][0], x1 = acc[ai][0][m][1];
                        float ss = (x0[0] * x0[0] + x0[1] * x0[1]) + (x0[2] * x0[2] + x0[3] * x0[3]) + (x1[0] * x1[0] + x1[1] * x1[1]) + (x1[2] * x1[2] + x1[3] * x1[3]);
                        ss = sum_fq(ss);
                        const float r = rsqrtf(ss * (1.f / 32.f) + EPS);
                        const f32x4 y0 = x0 * r * ga, y1 = x1 * r * gb;
                        f32x4 q0, q1;
#pragma unroll
                        for (int i = 0; i < 4; ++i) { q0[i] = other_half(y0[i]); q1[i] = other_half(y1[i]); }
                        const f32x4 c0 = *(const f32x4*)(cosT + row * 16 + 8 * (fq & 1)), c1 = *(const f32x4*)(cosT + row * 16 + 8 * (fq & 1) + 4);
                        const f32x4 s0 = *(const f32x4*)(sinT + row * 16 + 8 * (fq & 1)), s1 = *(const f32x4*)(sinT + row * 16 + 8 * (fq & 1) + 4);
                        const f32x4 o0 = (fq < 2) ? y0 * c0 - q0 * s0 : y0 * c0 + q0 * s0, o1 = (fq < 2) ? y1 * c1 - q1 * s1 : y1 * c1 + q1 * s1;
                        u32x4 w; w.x = pg8::cvt_pk_bf16(o0[0], o0[1]); w.y = pg8::cvt_pk_bf16(o0[2], o0[3]); w.z = pg8::cvt_pk_bf16(o1[0], o1[1]); w.w = pg8::cvt_pk_bf16(o1[2], o1[3]);
                        *(u32x4*)(KR + row * 32 + 8 * fq) = w; }
            }
        }
    }
};
struct EpiHeads {
    static constexpr bool PERM = true, AFTER_DRAIN = false;
    bf16_t *A, *B; const float* g; const float* ssq; float scl, invk; int ldB, pad_;
    __device__ __forceinline__ void operator()(const f32x4 (&acc)[2][2][4][2], const pg8::Unit& u, int wr, int wc, int fr, int fq) const {
        const int row0 = u.pm * 256 + wr * 64 + fr;
        const bool norm = u.pn < 2;
        bf16_t* dst = norm ? A + (4 * u.pn + wc) * 64 : B + (4 * (u.pn - 2) + wc) * 64;
        epi_store_heads(acc, row0, fq, norm, g, scl, dst, norm ? 512 : ldB, ssq, invk);
    }
};
struct EpiRes {
    static constexpr bool PERM = true, AFTER_DRAIN = false;
    const float* xin; float* xout; const float* gate;
    bf16_t* hn; const float* an; float* ssqn;
    __device__ __forceinline__ void operator()(const f32x4 (&acc)[2][2][4][2], const pg8::Unit& u, int wr, int wc, int fr, int fq) const {
        const int row0 = u.pm * 256 + wr * 64 + fr;
        const float* gp = gate + (size_t)(u.pm >> 5) * NMOD;
        float sq[2][4];
#pragma unroll
        for (int ai = 0; ai < 2; ++ai)
#pragma unroll
            for (int m = 0; m < 4; ++m) sq[ai][m] = 0.f;
#pragma unroll
        for (int bj = 0; bj < 2; ++bj) {
            const int col = u.pn * 256 + wc * 64 + bj * 32 + fq * 8;
            const f32x4 gv0 = *(const f32x4*)(gp + col), gv1 = *(const f32x4*)(gp + col + 4);
            f32x4 av0 = {0.f, 0.f, 0.f, 0.f}, av1 = av0; if (hn) { av0 = *(const f32x4*)(an + (size_t)(u.pm >> 5) * D + col); av1 = *(const f32x4*)(an + (size_t)(u.pm >> 5) * D + col + 4); }
#pragma unroll
            for (int ai = 0; ai < 2; ++ai)
#pragma unroll
                for (int m = 0; m < 4; ++m) { const size_t off = (size_t)(row0 + ai * 128 + m * 16) * D + col;
                    const f32x4 x0 = *(const f32x4*)(xin + off) + gv0 * acc[ai][bj][m][0], x1 = *(const f32x4*)(xin + off + 4) + gv1 * acc[ai][bj][m][1];
                    *(f32x4*)(xout + off) = x0; *(f32x4*)(xout + off + 4) = x1;
                    if (hn) { const f32x4 h0 = x0 * av0, h1 = x1 * av1; u32x4 w; w.x = pg8::cvt_pk_bf16(h0[0], h0[1]); w.y = pg8::cvt_pk_bf16(h0[2], h0[3]); w.z = pg8::cvt_pk_bf16(h1[0], h1[1]); w.w = pg8::cvt_pk_bf16(h1[2], h1[3]);
                        *(u32x4*)(hn + off) = w;
                        sq[ai][m] += (x0[0] * x0[0] + x0[1] * x0[1]) + (x0[2] * x0[2] + x0[3] * x0[3]) + (x1[0] * x1[0] + x1[1] * x1[1]) + (x1[2] * x1[2] + x1[3] * x1[3]); } }
        }
        if (hn) {
#pragma unroll
            for (int ai = 0; ai < 2; ++ai)
#pragma unroll
                for (int m = 0; m < 4; ++m) { float s = sq[ai][m]; s = sum_fq(s);
                    if (fq == 0) atomicAdd(ssqn + row0 + ai * 128 + m * 16, s); }
        }
    }
};
__device__ __forceinline__ float silu_f(float x) { return x * __builtin_amdgcn_rcpf(1.f + __builtin_amdgcn_exp2f(-x * LOG2E)); }
struct EpiGU {
    static constexpr bool PERM = true, AFTER_DRAIN = false;
    bf16_t* act; const float *ssq, *bias;
    __device__ __forceinline__ void operator()(f32x4 (&acc)[2][2][4][2], const pg8::Unit& u, int wr, int wc, int fr, int fq) const {
        const int row0 = u.pm * 256 + wr * 64 + fr;
        epi_apply_norm(acc, row0, u.pn * 256 + wc * 32 + fq * 8, ssq, bias + (size_t)(u.pm >> 5) * N_GU);
#pragma unroll
        for (int ai = 0; ai < 2; ++ai)
#pragma unroll
            for (int m = 0; m < 4; ++m) {
                bf16_t* rowp = act + (size_t)(row0 + ai * 128 + m * 16) * DFF + u.pn * 128 + wc * 32 + fq * 8;
                float v[8];
#pragma unroll
                for (int n = 0; n < 2; ++n)
#pragma unroll
                    for (int i = 0; i < 4; ++i) v[4 * n + i] = silu_f(acc[ai][0][m][n][i]) * acc[ai][1][m][n][i];
                u32x4 w; w.x = pg8::cvt_pk_bf16(v[0], v[1]); w.y = pg8::cvt_pk_bf16(v[2], v[3]); w.z = pg8::cvt_pk_bf16(v[4], v[5]); w.w = pg8::cvt_pk_bf16(v[6], v[7]);
                *(u32x4*)rowp = w;
            }
    }
};

namespace att {
typedef short bf16x8 __attribute__((ext_vector_type(8)));
typedef short s16x4 __attribute__((ext_vector_type(4)));
typedef float f32x16 __attribute__((ext_vector_type(16)));
constexpr int KBUF = 64 * 208, OFF_K = 0, OFF_V = 2 * KBUF, OFF_BIAS = OFF_V + 2 * 8192, OFF_OST = 49152;
__device__ __forceinline__ s16x4 vtr(const LAS unsigned char* p) { return __builtin_bit_cast(s16x4, __builtin_amdgcn_ds_read_tr16_b64_v4i16((LAS s16x4*)p)); }
__device__ __forceinline__ float half_max(float m) { auto rr = __builtin_amdgcn_permlane32_swap(__float_as_uint(m), __float_as_uint(m), false, false); return fmaxf(__uint_as_float(rr[0]), __uint_as_float(rr[1])); }
__device__ __forceinline__ float half_sum(float m) { auto rr = __builtin_amdgcn_permlane32_swap(__float_as_uint(m), __float_as_uint(m), false, false); return __uint_as_float(rr[0]) + __uint_as_float(rr[1]); }

template <bool NA>
__device__ __forceinline__ void attn_unit(LAS unsigned char* lds, int b, int h, int ublk,
        const bf16_t* __restrict__ Qa, int ldq, const bf16_t* __restrict__ Qb,
        const bf16_t* __restrict__ Ka, int ldk, const bf16_t* __restrict__ Kb,
        const bf16_t* __restrict__ Vg, int ldv,
        const float* __restrict__ rpb, const float* __restrict__ og, bf16_t* __restrict__ outp,
        const float* __restrict__ cosT, const float* __restrict__ sinT, const float* __restrict__ qrg, float qrs,
        const float* __restrict__ kgn1, const float* __restrict__ kgn2) {
    constexpr int NDS = NA ? 4 : 6, KSTR = NA ? 144 : 208;
    int tid_ = threadIdx.x; asm volatile("" : "+v"(tid_));
    const int tid = tid_, lane = tid & 63, wid = __builtin_amdgcn_readfirstlane(tid >> 6), r32 = lane & 31, hi = lane >> 5;
    int t_lo, t_hi, w_lo, w_hi, qc = 0, cs = 0, R = 0; size_t tokq;
    if (NA) { const int R0 = 4 * ublk; R = R0 + (wid >> 1); qc = 32 * (wid & 1) + r32;
        t_lo = min(max(R0 - 4, 0), 120); t_hi = min(max(R0 - 1, 0), 120) + 8; w_lo = min(max(R - 4, 0), 120); w_hi = w_lo + 8;
        cs = min(max(qc - 8, 0), 48); tokq = (size_t)b * T + R * 64 + qc; }
    else { t_lo = 0; t_hi = T / 64; w_lo = 0; w_hi = T / 64; tokq = (size_t)b * T + ublk * 256 + wid * 32 + r32; }
    constexpr int SPR = KSTR / 16, DCH = NA ? 8 : 12;
    const bool has_k1 = wid + 8 < SPR;
    const bf16_t *ks0, *ks1, *vs0; size_t kst0, kst1;
#define ATT_KSRC(PIECE, SRC, STEP) do { const int s_ = 64 * (PIECE) + lane, row_ = s_ / SPR, c_ = s_ - row_ * SPR, cc_ = (c_ == DCH) ? 0 : c_; \
        if (NA || cc_ < 8) { SRC = Ka + ((size_t)b * T + row_) * ldk + h * 64 + cc_ * 8; STEP = (size_t)64 * ldk; } \
        else { SRC = Kb + ((size_t)b * T + row_) * 32 + (cc_ - 8) * 8; STEP = (size_t)64 * 32; } } while (0)
    ATT_KSRC(wid, ks0, kst0);
    ATT_KSRC(has_k1 ? wid + 8 : wid, ks1, kst1);
#undef ATT_KSRC
    { const int s_ = 64 * wid + lane, dh_ = s_ >> 8, row_ = (s_ >> 2) & 63, c3_ = s_ & 3; vs0 = Vg + ((size_t)b * T + row_) * ldv + h * 64 + (dh_ * 4 + c3_) * 8; }
#define ATT_DMA(TILE, BUF) do { \
        __builtin_amdgcn_global_load_lds((const unsigned*)(ks0 + (size_t)(TILE) * kst0), (LAS unsigned*)(lds + OFF_K + (BUF) * KBUF + wid * 1024), 16, 0, 0); \
        if (has_k1) __builtin_amdgcn_global_load_lds((const unsigned*)(ks1 + (size_t)(TILE) * kst1), (LAS unsigned*)(lds + OFF_K + (BUF) * KBUF + (wid + 8) * 1024), 16, 0, 0); \
        __builtin_amdgcn_global_load_lds((const unsigned*)(vs0 + (size_t)(TILE) * 64 * ldv), (LAS unsigned*)(lds + OFF_V + (BUF) * 8192 + wid * 1024), 16, 0, 0); } while (0)
    ATT_DMA(t_lo, 0);
    bf16x8 qf[NDS];
    { const bf16_t* qp = Qa + tokq * ldq + h * 64 + hi * 8;
#pragma unroll
      for (int ds = 0; ds < 4; ++ds) qf[ds] = *(const bf16x8*)(qp + ds * 16);
      if (!NA) { const bf16_t* qp2 = Qb + tokq * 256 + h * 32 + hi * 8;
          const u32x4 ua = *(const u32x4*)qp2, ub = *(const u32x4*)(qp2 + 16);
          float x1[8], x2[8]; float ss = 0.f;
#pragma unroll
          for (int i = 0; i < 4; ++i) { x1[2 * i] = bf_lo(ua[i]); x1[2 * i + 1] = bf_hi(ua[i]); x2[2 * i] = bf_lo(ub[i]); x2[2 * i + 1] = bf_hi(ub[i]); }
#pragma unroll
          for (int i = 0; i < 8; ++i) ss += x1[i] * x1[i] + x2[i] * x2[i];
          const float rs = rsqrtf(half_sum(ss) * (1.f / 32.f) + EPS) * qrs;
          u32x4 wa, wb;
#pragma unroll
          for (int i = 0; i < 4; ++i) {
              float o1[2], o2[2];
#pragma unroll
              for (int j = 0; j < 2; ++j) { const int e = 8 * hi + 2 * i + j; const float cc = cosT[tokq * 16 + e], sn = sinT[tokq * 16 + e];
                  const float y1 = x1[2 * i + j] * rs * qrg[e], y2 = x2[2 * i + j] * rs * qrg[16 + e];
                  o1[j] = y1 * cc - y2 * sn; o2[j] = y2 * cc + y1 * sn; }
              wa[i] = pg8::cvt_pk_bf16(o1[0], o1[1]); wb[i] = pg8::cvt_pk_bf16(o2[0], o2[1]); }
          qf[NDS - 2] = __builtin_bit_cast(bf16x8, wa); qf[NDS - 1] = __builtin_bit_cast(bf16x8, wb); } }
    if (NA) { if (tid < 480) { const int dr = tid >> 5, dc = tid & 31; ((LAS float*)(lds + OFF_BIAS))[tid] = dc < 31 ? rpb[dr * 31 + dc] * LOG2E : 0.f; } }
    float mref;
    { float qn2 = 0.f;
#pragma unroll
      for (int ds = 0; ds < NDS; ++ds) { const u32x4 u = __builtin_bit_cast(u32x4, qf[ds]);
#pragma unroll
          for (int i = 0; i < 4; ++i) { const float a = bf_lo(u[i]), bq = bf_hi(u[i]); qn2 += a * a + bq * bq; } }
      qn2 = half_sum(qn2);
      float g1 = kgn1[lane]; g1 *= g1;
      float g2 = 0.f; if (!NA) { g2 = kgn2[lane & 31]; g2 *= g2; }
      float bm = 0.f; if (NA) { for (int i = lane; i < 15 * 31; i += 64) bm = fmaxf(bm, rpb[i]); }
      g1 = wave_max(g1); g2 = wave_max(g2); if (NA) bm = wave_max(bm);
      mref = sqrtf(qn2 * (64.f * g1 + 32.f * g2)) * 1.02f + 1.f + bm * LOG2E; }
    f32x16 negm;
#pragma unroll
    for (int r = 0; r < 16; ++r) negm[r] = -mref;
    __syncthreads();
    float l_run = 0.f;
    f32x16 o0 = {}, o1 = {};
    const int pim = (r32 & 0x13) | ((r32 & 4) << 1) | ((r32 & 8) >> 1);
    const int koff = pim * KSTR + hi * 16;
    const int voff = (8 * hi + ((lane & 15) >> 2)) * 64 + (16 * ((lane >> 4) & 1) + 4 * (lane & 3)) * 2;
    for (int t = t_lo; t < t_hi; ++t) {
        const int cur = (t - t_lo) & 1;
        const bool more = t + 1 < t_hi;
        if (more) ATT_DMA(t + 1, cur ^ 1);
        if (t >= w_lo && t < w_hi) {
            const LAS unsigned char* a0 = lds + OFF_K + cur * KBUF + koff;
            f32x16 p0, p1;
            bf16x8 kf[2 * NDS];
#pragma unroll
            for (int ds = 0; ds < NDS; ++ds) { kf[2 * ds] = *(const LAS bf16x8*)(a0 + ds * 32); kf[2 * ds + 1] = *(const LAS bf16x8*)(a0 + 32 * KSTR + ds * 32); }
            __builtin_amdgcn_sched_barrier(0);
#pragma unroll
            for (int ds = 0; ds < NDS; ++ds) {
                if (ds == 0) { p0 = __builtin_amdgcn_mfma_f32_32x32x16_bf16(kf[0], qf[0], negm, 0, 0, 0); p1 = __builtin_amdgcn_mfma_f32_32x32x16_bf16(kf[1], qf[0], negm, 0, 0, 0); }
                else { p0 = __builtin_amdgcn_mfma_f32_32x32x16_bf16(kf[2 * ds], qf[ds], p0, 0, 0, 0); p1 = __builtin_amdgcn_mfma_f32_32x32x16_bf16(kf[2 * ds + 1], qf[ds], p1, 0, 0, 0); }
            }
            const LAS unsigned char* va = lds + OFF_V + cur * 8192 + voff;
            s16x4 vl0[4], vh0[4], vl1[4], vh1[4];
#pragma unroll
            for (int s = 0; s < 4; ++s) { vl0[s] = vtr(va + s * 1024); vh0[s] = vtr(va + s * 1024 + 256); vl1[s] = vtr(va + 4096 + s * 1024); vh1[s] = vtr(va + 4096 + s * 1024 + 256); }
            __builtin_amdgcn_sched_barrier(0);
            if (NA) {
                const LAS float* bt = (const LAS float*)(lds + OFF_BIAS) + (t - R + 7) * 32;
#pragma unroll
                for (int r = 0; r < 16; ++r) {
                    const int kc0 = 16 * (r >> 3) + 8 * hi + (r & 7), kc1 = kc0 + 32;
                    const int i0 = min(max(kc0 - qc + 15, 0), 30), i1 = min(max(kc1 - qc + 15, 0), 30);
                    p0[r] = ((unsigned)(kc0 - cs) < 16u) ? p0[r] + bt[i0] : -1e30f;
                    p1[r] = ((unsigned)(kc1 - cs) < 16u) ? p1[r] + bt[i1] : -1e30f;
                }
            }
            float ps0 = 0.f, ps1 = 0.f;
#pragma unroll
            for (int r = 0; r < 16; ++r) { p0[r] = __builtin_amdgcn_exp2f(p0[r]); p1[r] = __builtin_amdgcn_exp2f(p1[r]); ps0 += p0[r]; ps1 += p1[r]; }
            l_run += ps0 + ps1;
            bf16x8 pb[4];
#pragma unroll
            for (int s = 0; s < 4; ++s) { const int bs = 8 * (s & 1); u32x4 w;
                if (s < 2) { w.x = pg8::cvt_pk_bf16(p0[bs], p0[bs + 1]); w.y = pg8::cvt_pk_bf16(p0[bs + 2], p0[bs + 3]); w.z = pg8::cvt_pk_bf16(p0[bs + 4], p0[bs + 5]); w.w = pg8::cvt_pk_bf16(p0[bs + 6], p0[bs + 7]); }
                else { w.x = pg8::cvt_pk_bf16(p1[bs], p1[bs + 1]); w.y = pg8::cvt_pk_bf16(p1[bs + 2], p1[bs + 3]); w.z = pg8::cvt_pk_bf16(p1[bs + 4], p1[bs + 5]); w.w = pg8::cvt_pk_bf16(p1[bs + 6], p1[bs + 7]); }
                pb[s] = __builtin_bit_cast(bf16x8, w); }
#pragma unroll
            for (int s = 0; s < 4; ++s) {
                const bf16x8 vf0 = {vl0[s][0], vl0[s][1], vl0[s][2], vl0[s][3], vh0[s][0], vh0[s][1], vh0[s][2], vh0[s][3]}, vf1 = {vl1[s][0], vl1[s][1], vl1[s][2], vl1[s][3], vh1[s][0], vh1[s][1], vh1[s][2], vh1[s][3]};
                o0 = __builtin_amdgcn_mfma_f32_32x32x16_bf16(vf0, pb[s], o0, 0, 0, 0);
                o1 = __builtin_amdgcn_mfma_f32_32x32x16_bf16(vf1, pb[s], o1, 0, 0, 0);
            }
        }
        __syncthreads();
    }
#undef ATT_DMA
    const float inv = 1.f / half_sum(l_run);
    float ss = 0.f;
#pragma unroll
    for (int r = 0; r < 16; ++r) { o0[r] *= inv; o1[r] *= inv; ss += o0[r] * o0[r] + o1[r] * o1[r]; }
    ss = half_sum(ss);
    const float rn = rsqrtf(ss * (1.f / 64.f) + EPS);
    LAS unsigned char* stg = lds + OFF_OST + wid * 4608;
#pragma unroll
    for (int rq = 0; rq < 4; ++rq) {
        const int d0 = 8 * rq + 4 * hi;
        const f32x4 g0 = *(const f32x4*)(og + d0), g1 = *(const f32x4*)(og + 32 + d0);
        u32x2 w0, w1;
        w0.x = pg8::cvt_pk_bf16(o0[4 * rq] * rn * g0[0], o0[4 * rq + 1] * rn * g0[1]); w0.y = pg8::cvt_pk_bf16(o0[4 * rq + 2] * rn * g0[2], o0[4 * rq + 3] * rn * g0[3]);
        w1.x = pg8::cvt_pk_bf16(o1[4 * rq] * rn * g1[0], o1[4 * rq + 1] * rn * g1[1]); w1.y = pg8::cvt_pk_bf16(o1[4 * rq + 2] * rn * g1[2], o1[4 * rq + 3] * rn * g1[3]);
        *(LAS u32x2*)(stg + r32 * 144 + d0 * 2) = w0; *(LAS u32x2*)(stg + r32 * 144 + (32 + d0) * 2) = w1;
    }
    LDS_WAIT();
    bf16_t* ob = outp + (tokq - r32) * 1024;
#pragma unroll
    for (int i = 0; i < 4; ++i) { const int row = i * 8 + (lane >> 3), ch = lane & 7;
        const u32x4 v = *(const LAS u32x4*)(stg + row * 144 + ch * 16);
        *(u32x4*)(ob + (size_t)row * 1024 + ch * 8) = v; }
    LDS_WAIT();
}
}

#define XB_TMO      128
#define XB_XCNT(j)  (256  + 64 * (j))
#define XB_XSUB(j)  (1280 + 64 * (j))
#define XB_XGEN(j)  (2304 + 64 * (j))
#define XB_TOP      3328
#define XB_TOPGEN   3392
#define XCD_BAR_WORDS 3456
#define XB_SPIN_CAP (1u << 18)

__device__ __forceinline__ unsigned xb_ld(unsigned* p)              { return __hip_atomic_load(p, __ATOMIC_RELAXED, __HIP_MEMORY_SCOPE_AGENT); }
__device__ __forceinline__ unsigned xb_add(unsigned* p, unsigned v) { return __hip_atomic_fetch_add(p, v, __ATOMIC_RELAXED, __HIP_MEMORY_SCOPE_AGENT); }
__device__ __forceinline__ unsigned xb_xcc_id() { return (unsigned)__builtin_amdgcn_s_getreg((3 << 11) | 20) & 0xFu; }
#define XB_SPIN(cond, bar) do { unsigned _sp = 0; while (cond) { __builtin_amdgcn_s_sleep(1); \
    if ((++_sp & 255u) == 0u) { if (xb_ld(&(bar)[XB_TMO])) break; if (_sp > XB_SPIN_CAP) { atomicAdd(&(bar)[XB_TMO], 1u); break; } } } } while (0)

struct XcdBarrier {
    unsigned* bar; unsigned x;
    volatile LAS unsigned* st;
};

__device__ __forceinline__ XcdBarrier xcd_barrier_post(unsigned* bar, volatile LAS unsigned* st) {
    XcdBarrier b; b.bar = bar; b.x = xb_xcc_id(); b.st = st;
    if (threadIdx.x == 0) (void)xb_add(&bar[XB_XCNT(b.x)], 1u);
    return b;
}
__device__ __forceinline__ void xcd_barrier_complete(unsigned* bar, unsigned x, unsigned& nloc, unsigned& nx) {
    const unsigned G = gridDim.x * gridDim.y * gridDim.z;
    unsigned sum, cnt, mine, sp = 0u;
    for (;;) {
        sum = 0u; cnt = 0u; mine = 0u;
#pragma unroll
        for (unsigned j = 0; j < 16; ++j) { const unsigned c = xb_ld(&bar[XB_XCNT(j)]); sum += c; cnt += (c > 0u) ? 1u : 0u; mine = (j == x) ? c : mine; }
        if (sum == G) break;
        __builtin_amdgcn_s_sleep(1);
        if ((++sp & 255u) == 0u) { if (xb_ld(&bar[XB_TMO])) break; if (sp > XB_SPIN_CAP) { atomicAdd(&bar[XB_TMO], 1u); break; } }
    }
    nloc = mine > 0u ? mine : 1u; nx = cnt > 0u ? cnt : 1u;
}

__device__ __forceinline__ void xcd_barrier(const XcdBarrier& b) {
    asm volatile("s_waitcnt vmcnt(0)" ::: "memory");
    __syncthreads();
    if (threadIdx.x == 0) {
        unsigned* bar = b.bar;
        __builtin_amdgcn_s_waitcnt(0);
        unsigned nloc = b.st[0], nx = b.st[1];
        if (nloc == 0u) { xcd_barrier_complete(bar, b.x, nloc, nx); b.st[0] = nloc; b.st[1] = nx; }
        const unsigned old = xb_add(&bar[XB_XSUB(b.x)], 1u);
        const unsigned gen = old / nloc;
        if (old + 1u == (gen + 1u) * nloc) {
            __builtin_amdgcn_fence(__ATOMIC_RELEASE, "agent");
            asm volatile("s_waitcnt vmcnt(0)" ::: "memory");
            const unsigned og = xb_add(&bar[XB_TOP], 1u);
            const unsigned tg = og / nx;
            if (og + 1u == (tg + 1u) * nx) xb_add(&bar[XB_TOPGEN], 1u);
            else XB_SPIN(xb_ld(&bar[XB_TOPGEN]) == tg, bar);
            __builtin_amdgcn_fence(__ATOMIC_ACQUIRE, "agent");
            xb_add(&bar[XB_XGEN(b.x)], 1u);
            asm volatile("s_waitcnt vmcnt(0)" ::: "memory");
        } else {
            XB_SPIN(xb_ld(&bar[XB_XGEN(b.x)]) == gen, bar);
            __builtin_amdgcn_fence(__ATOMIC_ACQUIRE, "agent");
            asm volatile("s_waitcnt vmcnt(0)" ::: "memory");
        }
    }
    __syncthreads();
}

struct Params {
    const float* in[25]; float* out; unsigned char* ws;
    int ph_lo, ph_hi, coop, pad;
    float inv_freq[16];
};
constexpr int NPHASES = 1 + 9 * DEPTH;
constexpr int LDS_BYTES = 131072 + 1024;

__global__ void __launch_bounds__(NTHREADS) fwd_kernel(Params p) {
    extern __shared__ __attribute__((aligned(16))) unsigned char lds_raw[];
    LAS unsigned char* lds = (LAS unsigned char*)lds_raw;
    const int G = gridDim.x, bid = blockIdx.x;
#define PHASE_IDS() int tid = threadIdx.x; asm volatile("" : "+v"(tid)); const int lane = tid & 63, wave = __builtin_amdgcn_readfirstlane(tid >> 6); const int gw = bid * NWAVES + wave; (void)gw; (void)lane
    const int vcu = (G % 8 == 0) ? (bid % 8) * (G / 8) + bid / 8 : bid;
    const int NGW = G * NWAVES;
    unsigned char* ws = p.ws;
    const float* x0 = p.in[0]; const float* cvec = p.in[1]; const int* pos = (const int*)p.in[2];
    float* mod = (float*)(ws + WS_MOD); float* cosT = (float*)(ws + WS_COS); float* sinT = (float*)(ws + WS_SIN);
    bf16_t* H = (bf16_t*)(ws + WS_H); bf16_t* Vb = (bf16_t*)(ws + WS_V); float* SSQ2 = (float*)(ws + WS_SSQ2);
    float* XA = (float*)(ws + WS_XA);
    float* SSQ = (float*)(ws + WS_SSQ); float* BIASIN = (float*)(ws + WS_BIASIN); float* BIASGU = (float*)(ws + WS_BIASGU); float* AVEC = (float*)(ws + WS_AVEC);
    bf16_t* QNA = (bf16_t*)(ws + WS_QNA); bf16_t* KNA = (bf16_t*)(ws + WS_KNA); bf16_t* VNA = (bf16_t*)(ws + WS_VNA);
    bf16_t* P = (bf16_t*)(ws + WS_P); bf16_t* QN = (bf16_t*)(ws + WS_QN); bf16_t* KN = (bf16_t*)(ws + WS_KN); bf16_t* QR = (bf16_t*)(ws + WS_QR);
    bf16_t* KR = (bf16_t*)(ws + WS_KR); bf16_t* MIX = (bf16_t*)(ws + WS_MIX); bf16_t* ACT = (bf16_t*)(ws + WS_ACT);
    cg::grid_group grid = cg::this_grid();
    const int lo = p.ph_lo, hi = p.ph_hi;
#ifndef REP_P0
#define REP_P0 0
#endif
#ifndef REP_MASK
#define REP_MASK 0
#endif
#ifndef PH_MASK
#define PH_MASK 0x3ff
#endif
#define IN_PH(k) (lo <= (k) && (k) < hi)
#define IN_PHL(c) (((PH_MASK >> ((c) + 1)) & 1) && lo <= (pb + (c)) && (pb + (c)) < hi)
#define SEAM(k) do { if (IN_PH(k) && IN_PH((k) + 1)) xcd_barrier(xbar); } while (0)
    LAS unsigned* misc = (LAS unsigned*)(lds + 131072);
    unsigned* barw = (unsigned*)(ws + WS_BAR);
    if (threadIdx.x < 16) misc[threadIdx.x] = 0u;
    if (p.coop && bid == 0) for (int i = threadIdx.x; i < XCD_BAR_WORDS; i += NTHREADS) __hip_atomic_store(barw + i, 0u, __ATOMIC_RELAXED, __HIP_MEMORY_SCOPE_AGENT);
    __syncthreads();
    XcdBarrier xbar; xbar.bar = barw; xbar.x = 0; xbar.st = (volatile LAS unsigned*)misc;

    if ((PH_MASK & 1) && IN_PH(0)) for (int rep0_ = 0; rep0_ <= REP_P0; ++rep0_) {
        PHASE_IDS();
        { LAS float* red = (LAS float*)lds; LAS float* sc = (LAS float*)(lds + 8192);
          for (int i = tid; i < 4 * D; i += NTHREADS) { const float cv = cvec[i]; sc[i] = cv / (1.f + __expf(-cv)); }
          __syncthreads();
          for (int item = bid; item < 2 * NMOD / 64; item += G) {
            const int col = item * 64 + lane, l = col / NMOD, j = col % NMOD;
            const float* wp = p.in[5] + ((size_t)l * D + wave * 128) * NMOD + j;
            const LAS float* scw = sc + wave * 128;
            float a0 = 0.f, a1 = 0.f, a2 = 0.f, a3 = 0.f;
#pragma unroll 1
            for (int k0 = 0; k0 < 128; k0 += 32) { float w[32];
#pragma unroll
                for (int k = 0; k < 32; ++k) w[k] = wp[(size_t)(k0 + k) * NMOD];
#pragma unroll
                for (int k = 0; k < 32; ++k) { a0 += scw[k0 + k] * w[k]; a1 += scw[D + k0 + k] * w[k]; a2 += scw[2 * D + k0 + k] * w[k]; a3 += scw[3 * D + k0 + k] * w[k]; } }
            red[(wave * 4 + 0) * 64 + lane] = a0; red[(wave * 4 + 1) * 64 + lane] = a1; red[(wave * 4 + 2) * 64 + lane] = a2; red[(wave * 4 + 3) * 64 + lane] = a3;
            __syncthreads();
            if (wave < 4) { float s = p.in[6][(size_t)l * NMOD + j];
#pragma unroll
                for (int kc = 0; kc < 8; ++kc) s += red[(kc * 4 + wave) * 64 + lane];
                mod[((size_t)l * 4 + wave) * NMOD + j] = s; }
            __syncthreads();
          } }
        for (int i = bid * NTHREADS + tid; i < 3 * M; i += G * NTHREADS) SSQ[M + i] = 0.f;
        for (int i = bid * NTHREADS + tid; i < 4 * M; i += G * NTHREADS) SSQ2[i] = 0.f;
        for (int i = bid * NTHREADS + tid; i < M * 16; i += G * NTHREADS) {
            const int row = i >> 4, e = i & 15;
            const float ang = (float)pos[row] * p.inv_freq[e];
            double rev = (double)ang * 0.15915494309189535; rev -= rint(rev);
            const float fr = (float)rev;
            cosT[i] = __builtin_amdgcn_cosf(fr); sinT[i] = __builtin_amdgcn_sinf(fr);
        }
        { LAS float* scr = (LAS float*)(lds + wave * 16384);
          constexpr int I0 = (N_IN / 32) * (D / 64), I1 = (N_UQ / 32) * (K_UQ / 64), I2 = (N_UKV / 32) * (K_UKV / 64), I3 = (D / 32) * (D / 64), I4 = (N_GU / 32) * (D / 64), I5 = (D / 32) * (DFF / 64);
          constexpr int IPL = I0 + I1 + I2 + I3 + I4 + I5;
          for (int it = gw; it < DEPTH * IPL; it += NGW) {
            const int l = it / IPL; int r = it % IPL;
            bf16_t* wl = (bf16_t*)(ws + WS_W + (size_t)l * W_LAYER);
            if (r < I0) { transpose_item(p.in[7] + (size_t)l * D * D_IN, D, D_IN, 0, (bf16_t*)((unsigned char*)wl + WO_IN), scr, r, N_IN / 32, lane); continue; } r -= I0;
            if (r < I1) { transpose_item(p.in[13] + (size_t)l * K_UQ * N_UQ, K_UQ, N_UQ, 1, (bf16_t*)((unsigned char*)wl + WO_UQ), scr, r, N_UQ / 32, lane, p.in[11] + (size_t)l * K_UQ); continue; } r -= I1;
            if (r < I2) { transpose_item(p.in[14] + (size_t)l * K_UKV * N_UKV, K_UKV, N_UKV, 2, (bf16_t*)((unsigned char*)wl + WO_UKV), scr, r, N_UKV / 32, lane, p.in[12] + (size_t)l * K_UKV); continue; } r -= I2;
            if (r < I3) { transpose_item(p.in[22] + (size_t)l * D * D, D, D, 3, (bf16_t*)((unsigned char*)wl + WO_OUT), scr, r, D / 32, lane); continue; } r -= I3;
            if (r < I4) { transpose_item(p.in[23] + (size_t)l * D * N_GU, D, N_GU, 4, (bf16_t*)((unsigned char*)wl + WO_GU), scr, r, N_GU / 32, lane); continue; } r -= I4;
            transpose_item(p.in[24] + (size_t)l * DFF * D, DFF, D, 5, (bf16_t*)((unsigned char*)wl + WO_DOWN), scr, r, D / 32, lane);
          } }
    }
    if (p.coop) { grid.sync(); xbar = xcd_barrier_post(barw, (volatile LAS unsigned*)misc); }

    for (int l = 0; l < DEPTH; ++l) {
        const int pb = 1 + 9 * l;
        const float* xin = (l == 0) ? x0 : p.out;
        const float* modl = mod + (size_t)l * 4 * NMOD;
        const unsigned char* wl = ws + WS_W + (size_t)l * W_LAYER;
        if (l == 0) {
        if (IN_PHL(0)) for (int rep_ = 0; rep_ <= ((REP_MASK >> 0) & 1); ++rep_) {
            PHASE_IDS();
            for (int i = bid * NTHREADS + tid; i < 2 * 2 * 4 * D; i += G * NTHREADS) {
                const int k = i & (D - 1), b = (i >> 10) & 3, which = (i >> 12) & 1, l2 = i >> 13;
                AVEC[i] = p.in[3 + which][(size_t)l2 * D + k] * (1.f + mod[((size_t)l2 * 4 + b) * NMOD + (which ? 4 : 1) * D + k]);
            }
            for (int rr = gw; rr < 2 * (N_IN + N_GU); rr += NGW) {
                const int l2 = rr / (N_IN + N_GU), r2 = rr % (N_IN + N_GU); const bool isgu = r2 >= N_IN; const int n = isgu ? r2 - N_IN : r2;
                const bf16_t* wrow = (const bf16_t*)(ws + WS_W + (size_t)l2 * W_LAYER + (isgu ? WO_GU : WO_IN)) + (size_t)n * D + 16 * lane;
                const u32x4 wa = *(const u32x4*)wrow, wb = *(const u32x4*)(wrow + 8);
                float wv[16];
#pragma unroll
                for (int i = 0; i < 4; ++i) { wv[2 * i] = bf_lo(wa[i]); wv[2 * i + 1] = bf_hi(wa[i]); wv[8 + 2 * i] = bf_lo(wb[i]); wv[8 + 2 * i + 1] = bf_hi(wb[i]); }
                float s4[4];
#pragma unroll
                for (int b = 0; b < 4; ++b) { const float* sh = mod + ((size_t)l2 * 4 + b) * NMOD + (isgu ? 3 : 0) * D + 16 * lane; float s = 0.f;
#pragma unroll
                    for (int i = 0; i < 16; ++i) s += sh[i] * wv[i];
                    s4[b] = wave_sum(s); }
                if (lane < 4) { float* bo = isgu ? BIASGU + ((size_t)l2 * 4 + lane) * N_GU + n : BIASIN + ((size_t)l2 * 4 + lane) * N_IN + n;
                    *bo = lane == 0 ? s4[0] : lane == 1 ? s4[1] : lane == 2 ? s4[2] : s4[3]; }
            }
            const float* gn = p.in[3] + (size_t)l * D;
            for (int m0 = gw * 16; m0 < M; m0 += NGW * 16) {
                const int b = m0 / T; const float* mb = modl + (size_t)b * NMOD;
                f32x4 a[4];
#pragma unroll
                for (int j = 0; j < 4; ++j) { const int cc = 4 * lane + 256 * j; a[j] = *(const f32x4*)(gn + cc) * (*(const f32x4*)(mb + D + cc) + 1.f); }
                for (int r = 0; r < 16; ++r) {
                    const f32x4* xr = (const f32x4*)(xin + (size_t)(m0 + r) * D) + lane;
                    f32x4 v[4]; float ss = 0.f;
#pragma unroll
                    for (int j = 0; j < 4; ++j) { v[j] = xr[64 * j]; ss += (v[j][0] * v[j][0] + v[j][1] * v[j][1]) + (v[j][2] * v[j][2] + v[j][3] * v[j][3]); }
                    ss = wave_sum(ss);
                    if (lane == 0) SSQ[m0 + r] = ss;
                    u32x2* o8 = (u32x2*)(H + (size_t)(m0 + r) * D) + lane;
#pragma unroll
                    for (int j = 0; j < 4; ++j) { const f32x4 o = v[j] * a[j]; u32x2 w; w.x = pg8::cvt_pk_bf16(o[0], o[1]); w.y = pg8::cvt_pk_bf16(o[2], o[3]); o8[64 * j] = w; }
                }
            }
        }
        SEAM(pb + 0);
        }
        if (IN_PHL(1)) for (int rep_ = 0; rep_ <= ((REP_MASK >> 1) & 1); ++rep_) {
            pg8::Gemm g{H, (const bf16_t*)(wl + WO_IN), M, N_IN, D, D}; pg8::StaticOrder S; S.init(M, N_IN, G, bid);
            EpiIn E{ws, l, p.in[8] + l * 64, p.in[9] + l * 64, p.in[18] + l * 32, 0.125f * LOG2E};
            pg8::gemm_phase<EpiIn, pg8::StaticOrder, true, true>(lds, g, S, E);
        }
        SEAM(pb + 1);
        if (IN_PHL(3)) for (int rep_ = 0; rep_ <= ((REP_MASK >> 3) & 1); ++rep_) {
            { PHASE_IDS();
              const float* cw = p.in[19] + (size_t)l * 3 * 256; const float* cb = p.in[20] + (size_t)l * 256; const float* ong = p.in[21] + (size_t)l * D + 768;
              const f32x4 w0 = *(const f32x4*)(cw + 4 * lane), w1 = *(const f32x4*)(cw + 256 + 4 * lane), w2 = *(const f32x4*)(cw + 512 + 4 * lane), cbv = *(const f32x4*)(cb + 4 * lane), ogv = *(const f32x4*)(ong + 4 * lane);
              for (int m0 = gw * 16; m0 < M; m0 += NGW * 16) {
#pragma unroll 1
                for (int hb = 0; hb < 2; ++hb) {
                    const int mb0 = m0 + 8 * hb, tb0 = mb0 % T, seq0 = mb0 - tb0;
                    u32x2 xi[10], gc[10], gbu[8];
#pragma unroll
                    for (int i = 0; i < 10; ++i) { const int tt = min(max(tb0 - 1 + i, 0), T - 1); const bf16_t* q = P + (size_t)(seq0 + tt) * 1536;
                        xi[i] = *(const u32x2*)(q + 768 + 4 * lane); gc[i] = *(const u32x2*)(q + 1280 + 4 * lane); }
#pragma unroll
                    for (int r = 0; r < 8; ++r) gbu[r] = *(const u32x2*)(P + (size_t)(mb0 + r) * 1536 + 1024 + 4 * lane);
                    f32x4 uu[10];
#pragma unroll
                    for (int i = 0; i < 10; ++i) { const int tt = tb0 - 1 + i; const float mk = (tt >= 0 && tt < T) ? 1.f : 0.f;
                        uu[i] = (f32x4){bf_lo(xi[i].x) * bf_lo(gc[i].x), bf_hi(xi[i].x) * bf_hi(gc[i].x), bf_lo(xi[i].y) * bf_lo(gc[i].y), bf_hi(xi[i].y) * bf_hi(gc[i].y)} * mk; }
#pragma unroll
                    for (int r = 0; r < 8; ++r) {
                        const f32x4 gb = {bf_lo(gbu[r].x), bf_hi(gbu[r].x), bf_lo(gbu[r].y), bf_hi(gbu[r].y)};
                        const f32x4 y = gb * (w0 * uu[r] + w1 * uu[r + 1] + w2 * uu[r + 2] + cbv);
                        float ss = (y[0] * y[0] + y[1] * y[1]) + (y[2] * y[2] + y[3] * y[3]);
                        ss += __shfl_xor(ss, 1); ss += __shfl_xor(ss, 2); ss += __shfl_xor(ss, 4); ss += __shfl_xor(ss, 8);
                        const float rs = rsqrtf(ss * (1.f / 64.f) + EPS);
                        const f32x4 o = y * rs * ogv;
                        u32x2 w; w.x = pg8::cvt_pk_bf16(o[0], o[1]); w.y = pg8::cvt_pk_bf16(o[2], o[3]);
                        *(u32x2*)(MIX + (size_t)(mb0 + r) * D + 768 + 4 * lane) = w;
                    }
                }
              } }
#pragma unroll 1
            for (int which = 0; which < 2; ++which) {
                pg8::Gemm g{which ? P + 512 : P, (const bf16_t*)(wl + (which ? WO_UKV : WO_UQ)), M, which ? N_UKV : N_UQ, which ? K_UKV : K_UQ, 1536};
                pg8::StaticOrder S; S.init(M, g.N, G, bid);
                EpiHeads E{which ? KN : QN, which ? Vb : QR, which ? p.in[16] + l * 64 : p.in[15] + l * 64, SSQ2 + (size_t)(2 * l + which) * M,
                           which ? 1.f : 0.10206207261596575f * LOG2E, which ? 1.f / K_UKV : 1.f / K_UQ, which ? 512 : 256, 0};
                pg8::gemm_phase<EpiHeads, pg8::StaticOrder, true, true>(lds, g, S, E);
            }
        }
        SEAM(pb + 3);
        if (IN_PHL(4)) for (int rep_ = 0; rep_ <= ((REP_MASK >> 4) & 1); ++rep_) {
            const float* ong = p.in[21] + (size_t)l * D;
            for (int ui = vcu; ui < BATCH * 8 * 32; ui += G) {
                const int bh = ui >> 5, qb = ui & 31, b = bh >> 3, h = bh & 7;
                att::attn_unit<false>(lds, b, h, qb, QN, 512, QR, KN, 512, KR, Vb, 512, nullptr, ong + 256 + h * 64, MIX + 256 + h * 64, cosT, sinT, p.in[17] + l * 32, 0.10206207261596575f * LOG2E, p.in[16] + l * 64, p.in[18] + l * 32);
            }
            for (int ui = vcu; ui < BATCH * 4 * 32; ui += G) {
                const int bh = ui >> 5, gq = ui & 31, b = bh >> 2, h = bh & 3;
                att::attn_unit<true>(lds, b, h, gq, QNA, 256, nullptr, KNA, 256, nullptr, VNA, 256, p.in[10] + ((size_t)l * 4 + h) * 15 * 31, ong + h * 64, MIX + h * 64, nullptr, nullptr, nullptr, 0.f, p.in[9] + l * 64, nullptr);
            }
        }
        SEAM(pb + 4);
        if (IN_PHL(5)) for (int rep_ = 0; rep_ <= ((REP_MASK >> 5) & 1); ++rep_) {
            pg8::Gemm g{MIX, (const bf16_t*)(wl + WO_OUT), M, D, D, D}; pg8::StaticOrder S; S.init(M, D, G, bid);
            EpiRes E{xin, XA, modl + 2 * D, H, AVEC + (size_t)(2 * l + 1) * 4 * D, SSQ + (size_t)(2 * l + 1) * M};
            pg8::gemm_phase<EpiRes, pg8::StaticOrder, true, true>(lds, g, S, E);
        }
        SEAM(pb + 5);
        if (IN_PHL(7)) for (int rep_ = 0; rep_ <= ((REP_MASK >> 7) & 1); ++rep_) {
            pg8::Gemm g{H, (const bf16_t*)(wl + WO_GU), M, N_GU, D, D}; pg8::StaticOrder S; S.init(M, N_GU, G, bid);
            EpiGU E{ACT, SSQ + (size_t)(2 * l + 1) * M, BIASGU + (size_t)l * 4 * N_GU};
            pg8::gemm_phase<EpiGU, pg8::StaticOrder, true, true>(lds, g, S, E);
        }
        SEAM(pb + 7);
        if (IN_PHL(8)) for (int rep_ = 0; rep_ <= ((REP_MASK >> 8) & 1); ++rep_) {
            pg8::Gemm g{ACT, (const bf16_t*)(wl + WO_DOWN), M, D, DFF, DFF}; pg8::StaticOrder S; S.init(M, D, G, bid);
            EpiRes E{XA, p.out, modl + 5 * D, (l + 1 < DEPTH) ? H : nullptr, AVEC + (size_t)(2 * (l + 1)) * 4 * D, SSQ + (size_t)(2 * (l + 1)) * M};
            pg8::gemm_phase<EpiRes, pg8::StaticOrder, true, true>(lds, g, S, E);
        }
        SEAM(pb + 8);
    }
#undef IN_PH
#undef IN_PHL
#undef SEAM
}

#ifndef N_LAUNCH_MODE
#define N_LAUNCH_MODE 1
#endif
extern "C" void kernel_launch(void* const* d_in, const int* in_sizes, int n_in, void* d_out, int out_size, void* d_ws, size_t ws_size, hipStream_t stream) {
    static int grid = 0;
    if (grid == 0) {
        if (n_in != 25 || out_size != M * D || ws_size < WS_END) { fprintf(stderr, "kernel_launch: unexpected shapes (n_in %d out %d ws %zu)\n", n_in, out_size, ws_size); grid = -1; return; }
        int dev = 0, cus = 0, per_cu = 0;
        hipGetDevice(&dev); hipDeviceGetAttribute(&cus, hipDeviceAttributeMultiprocessorCount, dev);
        if (hipFuncSetAttribute((const void*)fwd_kernel, hipFuncAttributeMaxDynamicSharedMemorySize, LDS_BYTES) != hipSuccess) { fprintf(stderr, "kernel_launch: hipFuncSetAttribute failed\n"); grid = -1; return; }
        if (hipOccupancyMaxActiveBlocksPerMultiprocessor(&per_cu, (const void*)fwd_kernel, NTHREADS, LDS_BYTES) != hipSuccess || per_cu < 1) { fprintf(stderr, "kernel_launch: occupancy query says %d\n", per_cu); per_cu = 1; }
        (void)hipGetLastError();
        grid = cus;
    }
    if (grid < 0) return;
    Params p{};
    for (int i = 0; i < 25; ++i) p.in[i] = (const float*)d_in[i];
    p.out = (float*)d_out; p.ws = (unsigned char*)d_ws;
    for (int e = 0; e < 16; ++e) p.inv_freq[e] = (float)pow(10000.0, -(double)(2 * e) / 32.0);
#if N_LAUNCH_MODE == 1
    p.ph_lo = 0; p.ph_hi = NPHASES; p.coop = 1;
    void* args[] = {&p};
    hipError_t e = hipLaunchCooperativeKernel((const void*)fwd_kernel, dim3(grid), dim3(NTHREADS), args, LDS_BYTES, stream);
    if (e != hipSuccess) fprintf(stderr, "cooperative launch failed: %s (grid %d)\n", hipGetErrorString(e), grid);
#else
    for (int ph = 0; ph < NPHASES; ++ph) {
        p.ph_lo = ph; p.ph_hi = ph + 1; p.coop = 0;
        hipLaunchKernelGGL(fwd_kernel, dim3(grid), dim3(NTHREADS), LDS_BYTES, stream, p);
    }
#endif
}
```

```cpp
#include <hip/hip_runtime.h>
#include <hip/hip_cooperative_groups.h>
#include <cstdio>
#include <cstdint>
#include <cmath>
namespace cg = cooperative_groups;
namespace pg8 {
#define PG8_LAS __attribute__((address_space(3)))
typedef unsigned short bf16_t;
typedef short bf16x8 __attribute__((ext_vector_type(8)));
typedef float f32x4 __attribute__((ext_vector_type(4)));
typedef unsigned u32x4 __attribute__((ext_vector_type(4)));
constexpr int BM = 256, BK = 64, HALF = 128, HTB = HALF * BK * 2  , STAGE_BYTES = 8 * HTB, NXCD = 8, WGM = 8;

__host__ __device__ __forceinline__ int lds_byte(int r, int c) { const int st = (r >> 4) * 2 + (c >> 5), rr = r & 15, cc = c & 31, ob = rr * 64 + cc * 2; return st * 1024 + (ob ^ (((ob >> 9) & 1) << 5)); }
__host__ __device__ __forceinline__ void stage_rc(int b, int& R, int& C) { const int st = b / 1024, sb = b % 1024, swz = sb ^ (((sb >> 9) & 1) << 5); R = (st >> 1) * 16 + swz / 64; C = (st & 1) * 32 + (swz % 64) / 2; }
__host__ __device__ __forceinline__ int perm32(int rho) { const int n = rho >> 4, i = rho & 15; return 8 * (i >> 2) + 4 * n + (i & 3); }

struct Unit { int pm, pn; };
struct Gemm { const bf16_t* A; const bf16_t* Bt; int M, N, K, lda; };

struct StaticOrder {
    int nM, nN, nwg, G, c;
    __host__ __device__ void init(int M, int N, int G_, int c_) { nM = M / BM; nN = N / BM; nwg = nM * nN; G = G_; c = c_; }
    __host__ __device__ bool next(int i, Unit& u) const {
        const long L = (long)i * G + c; if (L >= nwg) return false;
        int wgid = (int)L; { const int q = nwg / NXCD, r = nwg % NXCD, xcd = wgid % NXCD, off = wgid / NXCD; wgid = (xcd < r ? xcd * (q + 1) : r * (q + 1) + (xcd - r) * q) + off; }
        const int nig = WGM * nN, gid = wgid / nig, fm = gid * WGM, gsz = (nM - fm) < WGM ? (nM - fm) : WGM;
        u.pm = fm + ((wgid % nig) % gsz); u.pn = (wgid % nig) / gsz; return true;
    }
    __device__ __forceinline__ void a_ready(const Unit&) const {}
    __device__ __forceinline__ void done(const Unit&) const {}
};
__device__ __forceinline__ unsigned cvt_pk_bf16(float lo, float hi) { unsigned r; asm volatile("v_cvt_pk_bf16_f32 %0, %1, %2" : "=v"(r) : "v"(lo), "v"(hi)); return r; }
template <class Epi, class Sched, bool ALIGN_EPI = false, bool SP2 = false>
__device__ __forceinline__ void gemm_phase(PG8_LAS unsigned char* lds, const Gemm g, const Sched& S, const Epi& E) {
    int tid_ = threadIdx.x; asm volatile("" : "+v"(tid_));
    const int tid = tid_, wid = __builtin_amdgcn_readfirstlane(tid >> 6), lane = tid & 63, wr = wid >> 2, wc = wid & 3, fr = lane & 15, fq = lane >> 4;
    const int K = g.K, nt = K / BK;
    unsigned voffA[2], voffB[2];
#pragma unroll
    for (int i = 0; i < 2; ++i) { int R, C; stage_rc(tid * 16 + i * 8192, R, C); const int Rb = Epi::PERM ? ((R & ~31) + perm32(R & 31)) : R;
        voffA[i] = (unsigned)(R * g.lda + C) * 2u; voffB[i] = (unsigned)(Rb * K + C) * 2u; }
    const size_t kstep = (size_t)(BK * 2);
    const size_t hstep = (size_t)HALF * K * 2;
    const size_t tstep = 2 * hstep; const size_t hstepA = (size_t)HALF * g.lda * 2, tstepA = 2 * hstepA;
    const unsigned ldsw = (unsigned)wid * 1024u;
    const int aoff = lds_byte(wr * 64 + fr, fq * 8), boff = lds_byte(wc * 32 + fr, fq * 8);
#define PG8_SA(b, h) (((b) * 2 + (h)) * HTB)
#define PG8_SB(b, h) ((4 + (b) * 2 + (h)) * HTB)
#define PG8_STAGE(bufoff, gbase, voff) do { _Pragma("unroll") for (int _i = 0; _i < 2; ++_i) \
        __builtin_amdgcn_global_load_lds((const unsigned*)((const char*)(gbase) + (voff)[_i]), (PG8_LAS unsigned*)(lds + (bufoff) + ldsw + _i * 8192), 16, 0, 0); } while (0)
#define PG8_LDA(dst, b, h) do { _Pragma("unroll") for (int m = 0; m < 4; ++m) _Pragma("unroll") for (int k = 0; k < 2; ++k) dst[m][k] = *(const PG8_LAS bf16x8*)(lds + PG8_SA(b, h) + aoff + m * 2048 + k * 1024); } while (0)
#define PG8_LDB(dst, b, h) do { _Pragma("unroll") for (int n = 0; n < 2; ++n) _Pragma("unroll") for (int k = 0; k < 2; ++k) dst[n][k] = *(const PG8_LAS bf16x8*)(lds + PG8_SB(b, h) + boff + n * 2048 + k * 1024); } while (0)
#define PG8_MMA(ai, bj, At, Bt) do { __builtin_amdgcn_s_setprio(1); _Pragma("unroll") for (int m = 0; m < 4; ++m) _Pragma("unroll") for (int n = 0; n < 2; ++n) _Pragma("unroll") for (int k = 0; k < 2; ++k) \
        acc[ai][bj][m][n] = __builtin_amdgcn_mfma_f32_16x16x32_bf16(Bt[n][k], At[m][k], acc[ai][bj][m][n], 0, 0, 0); __builtin_amdgcn_s_setprio(0); } while (0)
#define PG8_WAIT_V(n) asm volatile("s_waitcnt vmcnt(" #n ")" ::: "memory")
#define PG8_WAIT_L(n) asm volatile("s_waitcnt lgkmcnt(" #n ")" ::: "memory")
#define PG8_BAR __builtin_amdgcn_s_barrier()
#define PG8_SCHED __builtin_amdgcn_sched_barrier(0)
    Unit cur, nxt; int ui = 0;
    if (!S.next(0, cur)) return;
    f32x4 acc[2][2][4][2];
#pragma unroll
    for (int a = 0; a < 2; ++a)
#pragma unroll
        for (int b = 0; b < 2; ++b)
#pragma unroll
            for (int m = 0; m < 4; ++m)
#pragma unroll
                for (int n = 0; n < 2; ++n) acc[a][b][m][n] = (f32x4){0.f, 0.f, 0.f, 0.f};
    bf16x8 At[4][2], B0[2][2], B1[2][2];
    const char* cA = (const char*)g.A + (size_t)cur.pm * tstepA; const char* cB = (const char*)g.Bt + (size_t)cur.pn * tstep;
    S.a_ready(cur);
    if constexpr (SP2) {
        PG8_STAGE(PG8_SB(0, 0), cB, voffB); PG8_STAGE(PG8_SB(0, 1), cB + hstep, voffB); PG8_STAGE(PG8_SA(0, 0), cA, voffA); PG8_STAGE(PG8_SA(0, 1), cA + hstepA, voffA);
        if (wr == 1) PG8_BAR;
        PG8_WAIT_V(2); PG8_BAR;
        PG8_STAGE(PG8_SB(1, 0), cB + kstep, voffB); PG8_STAGE(PG8_SA(1, 0), cA + kstep, voffA); PG8_STAGE(PG8_SB(1, 1), cB + hstep + kstep, voffB);
        PG8_WAIT_V(6); PG8_BAR;
    } else {
        PG8_STAGE(PG8_SB(0, 0), cB, voffB); PG8_STAGE(PG8_SA(0, 0), cA, voffA); PG8_STAGE(PG8_SB(0, 1), cB + hstep, voffB); PG8_STAGE(PG8_SA(0, 1), cA + hstepA, voffA);
        if (wr == 1) PG8_BAR;
        PG8_WAIT_V(4); PG8_BAR;
        PG8_STAGE(PG8_SB(1, 0), cB + kstep, voffB); PG8_STAGE(PG8_SA(1, 0), cA + kstep, voffA); PG8_STAGE(PG8_SB(1, 1), cB + hstep + kstep, voffB);
        PG8_WAIT_V(6); PG8_BAR;
    }
    for (;;) {
        const bool has_next = S.next(ui + 1, nxt);
        const char* nA = has_next ? (const char*)g.A + (size_t)nxt.pm * tstepA : cA; const char* nB = has_next ? (const char*)g.Bt + (size_t)nxt.pn * tstep : cB;
        for (int t = 0; t < nt; t += 2) {
            const bool last = (t == nt - 2);
            const char* a1 = cA + (size_t)(t + 1) * kstep;
            const char* a2 = last ? nA : cA + (size_t)(t + 2) * kstep; const char* b2 = last ? nB : cB + (size_t)(t + 2) * kstep;
            const char* a3 = a2 + kstep; const char* b3 = b2 + kstep;
            if (last && has_next) S.a_ready(nxt);
            if constexpr (SP2) {
            PG8_LDB(B0, 0, 0); PG8_LDB(B1, 0, 1); PG8_SCHED; PG8_LDA(At, 0, 0); PG8_STAGE(PG8_SA(1, 1), a1 + hstepA, voffA);
            PG8_WAIT_V(8); PG8_WAIT_L(0); PG8_BAR; PG8_MMA(0, 0, At, B0); PG8_MMA(0, 1, At, B1); PG8_BAR; PG8_SCHED;
            PG8_LDA(At, 0, 1); PG8_STAGE(PG8_SB(0, 0), b2, voffB); PG8_STAGE(PG8_SB(0, 1), b2 + hstep, voffB); PG8_STAGE(PG8_SA(0, 0), a2, voffA);
            PG8_WAIT_V(8); PG8_WAIT_L(0); PG8_BAR; PG8_MMA(1, 0, At, B0); PG8_MMA(1, 1, At, B1); PG8_BAR; PG8_SCHED;
            PG8_LDB(B0, 1, 0); PG8_LDB(B1, 1, 1); PG8_SCHED; PG8_LDA(At, 1, 0); PG8_STAGE(PG8_SA(0, 1), a2 + hstepA, voffA);
            PG8_WAIT_V(8); PG8_WAIT_L(0); PG8_BAR; PG8_MMA(0, 0, At, B0); PG8_MMA(0, 1, At, B1); PG8_BAR; PG8_SCHED;
            PG8_LDA(At, 1, 1); PG8_STAGE(PG8_SB(1, 0), b3, voffB); PG8_STAGE(PG8_SB(1, 1), b3 + hstep, voffB); PG8_STAGE(PG8_SA(1, 0), a3, voffA);
            PG8_WAIT_V(8); PG8_WAIT_L(0); PG8_BAR; PG8_MMA(1, 0, At, B0); PG8_MMA(1, 1, At, B1); PG8_BAR; PG8_SCHED;
            } else {
            PG8_LDB(B0, 0, 0); PG8_SCHED; PG8_LDA(At, 0, 0); PG8_STAGE(PG8_SA(1, 1), a1 + hstepA, voffA);
            PG8_WAIT_L(8); PG8_BAR; PG8_WAIT_L(0); PG8_MMA(0, 0, At, B0); PG8_BAR; PG8_SCHED;
            PG8_LDB(B1, 0, 1); PG8_STAGE(PG8_SB(0, 0), b2, voffB);
            PG8_BAR; PG8_WAIT_L(0); PG8_MMA(0, 1, At, B1); PG8_BAR;
            PG8_LDA(At, 0, 1); PG8_STAGE(PG8_SA(0, 0), a2, voffA);
            PG8_BAR; PG8_WAIT_L(0); PG8_MMA(1, 0, At, B0); PG8_BAR; PG8_SCHED;
            PG8_STAGE(PG8_SB(0, 1), b2 + hstep, voffB);
            PG8_WAIT_V(6); PG8_BAR; PG8_MMA(1, 1, At, B1); PG8_BAR;
            PG8_LDB(B0, 1, 0); PG8_SCHED; PG8_LDA(At, 1, 0); PG8_STAGE(PG8_SA(0, 1), a2 + hstepA, voffA);
            PG8_WAIT_L(8); PG8_BAR; PG8_WAIT_L(0); PG8_MMA(0, 0, At, B0); PG8_BAR; PG8_SCHED;
            PG8_LDB(B1, 1, 1); PG8_STAGE(PG8_SB(1, 0), b3, voffB);
            PG8_BAR; PG8_WAIT_L(0); PG8_MMA(0, 1, At, B1); PG8_BAR;
            PG8_LDA(At, 1, 1); PG8_STAGE(PG8_SA(1, 0), a3, voffA);
            PG8_BAR; PG8_WAIT_L(0); PG8_MMA(1, 0, At, B0); PG8_BAR; PG8_SCHED;
            PG8_STAGE(PG8_SB(1, 1), b3 + hstep, voffB);
            PG8_WAIT_V(6); PG8_BAR; PG8_MMA(1, 1, At, B1); PG8_BAR;
            }
        }
        if constexpr (ALIGN_EPI) { if (wr == 0) PG8_BAR; }
        if constexpr (!Epi::AFTER_DRAIN) { E(acc, cur, wr, wc, fr, fq); S.done(cur); }
        if (!has_next) break;
#pragma unroll
        for (int a = 0; a < 2; ++a)
#pragma unroll
            for (int b = 0; b < 2; ++b)
#pragma unroll
                for (int m = 0; m < 4; ++m)
#pragma unroll
                    for (int n = 0; n < 2; ++n) acc[a][b][m][n] = (f32x4){0.f, 0.f, 0.f, 0.f};
        cur = nxt; cA = nA; cB = nB; ++ui;
        if constexpr (ALIGN_EPI) { if (wr == 1) PG8_BAR; }
    }
    PG8_WAIT_V(0);
    if constexpr (!ALIGN_EPI) { if (wr == 0) PG8_BAR; }
    PG8_BAR;
    if constexpr (Epi::AFTER_DRAIN) { E.fused(acc, cur, wr, wc, fr, fq, lds, wid, lane); S.done(cur); }
#undef PG8_SA
#undef PG8_SB
#undef PG8_STAGE
#undef PG8_LDA
#undef PG8_LDB
#undef PG8_MMA
#undef PG8_WAIT_V
#undef PG8_WAIT_L
#undef PG8_BAR
#undef PG8_SCHED
}
}

constexpr int BATCH = 4, T = 8192, D = 1024, M = BATCH * T, DEPTH = 2;
constexpr int D_IN = 2208, DFF = 2816, NMOD = 6 * D;
constexpr int N_IN = 2304, N_UQ = 768, K_UQ = 384, N_UKV = 1024, K_UKV = 256, N_GU = 5632;
constexpr float EPS = 1e-6f, LOG2E = 1.4426950408889634f;
constexpr int NWAVES = 8, NTHREADS = 512;

#define LAS __attribute__((address_space(3)))
typedef unsigned short bf16_t;
typedef float f32x4 __attribute__((ext_vector_type(4)));
typedef unsigned u32x4 __attribute__((ext_vector_type(4)));
typedef unsigned u32x2 __attribute__((ext_vector_type(2)));

constexpr size_t MiB = 1u << 20;
constexpr size_t WS_MOD = 0;
constexpr size_t WS_BAR = 512 * 1024;
constexpr size_t WS_COS = 1 * MiB, WS_SIN = 3 * MiB;
constexpr size_t WS_SSQ = 5 * MiB;
constexpr size_t WS_BIASIN = 5 * MiB + 512 * 1024, WS_BIASGU = WS_BIASIN + 2 * 4 * 2304 * 4;
constexpr size_t WS_AVEC = 5 * MiB + 832 * 1024;
constexpr size_t WS_W = 6 * MiB, W_LAYER = 26 * MiB;
constexpr size_t WO_IN = 0, WO_UQ = 4 * MiB + 512 * 1024, WO_UKV = 5 * MiB + 256 * 1024, WO_OUT = 6 * MiB, WO_GU = 8 * MiB, WO_DOWN = 19 * MiB;
constexpr size_t WS_H = 58 * MiB;
constexpr size_t WS_XA = 122 * MiB;
constexpr size_t WS_QNA = 250 * MiB, WS_KNA = 266 * MiB, WS_VNA = 282 * MiB;
constexpr size_t WS_P = 298 * MiB;
constexpr size_t WS_QN = 122 * MiB, WS_KN = 154 * MiB, WS_QR = 186 * MiB, WS_V = 202 * MiB, WS_KR = 234 * MiB;
constexpr size_t WS_MIX = 412 * MiB, WS_SSQ2 = 476 * MiB, WS_END = 477 * MiB;
constexpr size_t WS_ACT = 250 * MiB;

__device__ __forceinline__ unsigned f2bf(float f) { unsigned u = __builtin_bit_cast(unsigned, f); return (u + 0x7fffu + ((u >> 16) & 1u)) >> 16; }
__device__ __forceinline__ unsigned pk2(float lo, float hi) { return f2bf(lo) | (f2bf(hi) << 16); }
__device__ __forceinline__ float bf_lo(unsigned u) { return __builtin_bit_cast(float, u << 16); }
__device__ __forceinline__ float bf_hi(unsigned u) { return __builtin_bit_cast(float, u & 0xffff0000u); }
__device__ __forceinline__ float wave_sum(float v) {
#pragma unroll
    for (int o = 1; o < 64; o <<= 1) v += __shfl_xor(v, o);
    return v;
}
#define LDS_WAIT() asm volatile("s_waitcnt lgkmcnt(0)" ::: "memory")
template <int CTRL> __device__ __forceinline__ float dpp_xmax(float x) { return fmaxf(x, __int_as_float(__builtin_amdgcn_update_dpp(__float_as_int(x), __float_as_int(x), CTRL, 0xf, 0xf, false))); }
__device__ __forceinline__ float wave_max(float x) {
    x = dpp_xmax<0xB1>(x); x = dpp_xmax<0x4E>(x); x = dpp_xmax<0x141>(x); x = dpp_xmax<0x140>(x);
    auto a = __builtin_amdgcn_permlane16_swap(__float_as_uint(x), __float_as_uint(x), false, false); x = fmaxf(__uint_as_float(a[0]), __uint_as_float(a[1]));
    auto b = __builtin_amdgcn_permlane32_swap(__float_as_uint(x), __float_as_uint(x), false, false); return fmaxf(__uint_as_float(b[0]), __uint_as_float(b[1]));
}
__device__ __forceinline__ float sum_fq(float x) {
    auto a = __builtin_amdgcn_permlane16_swap(__float_as_uint(x), __float_as_uint(x), false, false); x = __uint_as_float(a[0]) + __uint_as_float(a[1]);
    auto b = __builtin_amdgcn_permlane32_swap(__float_as_uint(x), __float_as_uint(x), false, false); return __uint_as_float(b[0]) + __uint_as_float(b[1]);
}

__device__ __forceinline__ int src_col(int id, int c) {
    const int pn = c >> 8, r = c & 255, bj = r >> 7, wc = (r >> 5) & 3, jj = r & 31, lc = 64 * wc + 32 * bj + jj;
    switch (id) {
    case 0:
        if (pn < 3) return 256 * pn + lc;
        if (pn == 3) return 768 + lc;
        if (pn == 4) return lc < 128 ? 1024 + lc : (lc < 160 ? 1408 + (lc - 128) : -1);
        if (pn == 5) return 1152 + lc;
        return 1440 + 256 * (pn - 6) + lc;
    case 1:
        if (pn < 2) return (4 * pn + wc) * 96 + 32 * bj + jj;
        return (2 * wc + bj) * 96 + 64 + jj;
    case 2:
        if (pn < 2) return (4 * pn + wc) * 128 + 32 * bj + jj;
        return (4 * (pn - 2) + wc) * 128 + 64 + 32 * bj + jj;
    case 3: return 256 * pn + lc;
    case 4: return 128 * pn + 32 * wc + jj + (bj ? DFF : 0);
    default: return 256 * pn + lc;
    }
}
__device__ __forceinline__ void transpose_item(const float* __restrict__ W, int K, int Nsrc, int id, bf16_t* __restrict__ WT, LAS float* scr, int item, int nblk, int lane, const float* __restrict__ kgain = nullptr) {
    const int kb = item / nblk, nb = item % nblk, k0 = 64 * kb, n0 = 32 * nb;
    const int sc = src_col(id, n0 + (lane & 31));
    { const float* wp = W + (size_t)(k0 + (lane >> 5)) * Nsrc + (sc >= 0 ? sc : 0);
      float v[32];
#pragma unroll
      for (int i = 0; i < 32; ++i) v[i] = wp[(size_t)(2 * i) * Nsrc];
#pragma unroll
      for (int i = 0; i < 32; ++i) scr[(2 * i + (lane >> 5)) * 33 + (lane & 31)] = sc >= 0 ? v[i] * (kgain ? kgain[k0 + 2 * i + (lane >> 5)] : 1.f) : 0.f; }
    LDS_WAIT();
    const int c = lane & 7;
#pragma unroll
    for (int j = 0; j < 4; ++j) { const int n = (lane >> 3) + 8 * j; const LAS float* s = scr + (8 * c) * 33 + n;
        u32x4 o; o.x = pg8::cvt_pk_bf16(s[0 * 33], s[1 * 33]); o.y = pg8::cvt_pk_bf16(s[2 * 33], s[3 * 33]); o.z = pg8::cvt_pk_bf16(s[4 * 33], s[5 * 33]); o.w = pg8::cvt_pk_bf16(s[6 * 33], s[7 * 33]);
        *(u32x4*)(WT + (size_t)(n0 + n) * K + k0 + 8 * c) = o; }
    LDS_WAIT();
}

__device__ __forceinline__ float other_half(float x) { auto r = __builtin_amdgcn_permlane32_swap(__float_as_uint(x), __float_as_uint(x), false, false);
    return __uint_as_float((threadIdx.x & 32) ? r[0] : r[1]); }
__device__ __forceinline__ void epi_store_heads(const f32x4 (&acc)[2][2][4][2], int row0, int fq, bool norm, const float* __restrict__ g, float scl, bf16_t* __restrict__ dst, int ld, const float* __restrict__ rssq = nullptr, float invk = 0.f) {
#pragma unroll
    for (int ai = 0; ai < 2; ++ai)
#pragma unroll
        for (int m = 0; m < 4; ++m) {
            float r = 1.f, rl = 1.f;
            if (rssq) rl = rsqrtf(rssq[row0 + ai * 128 + m * 16] * invk + EPS);
            if (norm) { float ss = 0.f;
#pragma unroll
                for (int bj = 0; bj < 2; ++bj)
#pragma unroll
                    for (int n = 0; n < 2; ++n) { const f32x4 v = acc[ai][bj][m][n]; ss += (v[0] * v[0] + v[1] * v[1]) + (v[2] * v[2] + v[3] * v[3]); }
                ss = sum_fq(ss);
                r = rsqrtf(ss * rl * rl * (1.f / 64.f) + EPS) * scl; }
            r *= rl;
            bf16_t* rowp = dst + (size_t)(row0 + ai * 128 + m * 16) * ld + 8 * fq;
#pragma unroll
            for (int bj = 0; bj < 2; ++bj) {
                f32x4 g0 = {1.f, 1.f, 1.f, 1.f}, g1 = g0;
                if (norm) { g0 = *(const f32x4*)(g + 32 * bj + 8 * fq); g1 = *(const f32x4*)(g + 32 * bj + 8 * fq + 4); }
                const f32x4 v0 = acc[ai][bj][m][0] * r * g0, v1 = acc[ai][bj][m][1] * r * g1;
                u32x4 w; w.x = pg8::cvt_pk_bf16(v0[0], v0[1]); w.y = pg8::cvt_pk_bf16(v0[2], v0[3]); w.z = pg8::cvt_pk_bf16(v1[0], v1[1]); w.w = pg8::cvt_pk_bf16(v1[2], v1[3]);
                *(u32x4*)(rowp + 32 * bj) = w; }
        }
}
__device__ __forceinline__ void epi_apply_norm(f32x4 (&acc)[2][2][4][2], int row0, int gcol0  , const float* __restrict__ ssq, const float* __restrict__ bias) {
    f32x4 bv[2][2];
#pragma unroll
    for (int bj = 0; bj < 2; ++bj)
#pragma unroll
        for (int n = 0; n < 2; ++n) bv[bj][n] = *(const f32x4*)(bias + gcol0 + 128 * bj + 4 * n);
#pragma unroll
    for (int ai = 0; ai < 2; ++ai)
#pragma unroll
        for (int m = 0; m < 4; ++m) { const float rs = rsqrtf(ssq[row0 + ai * 128 + m * 16] * (1.f / D) + EPS);
#pragma unroll
            for (int bj = 0; bj < 2; ++bj)
#pragma unroll
                for (int n = 0; n < 2; ++n) acc[ai][bj][m][n] = acc[ai][bj][m][n] * rs + bv[bj][n]; }
}
struct EpiIn {
    static constexpr bool PERM = true, AFTER_DRAIN = false;
    unsigned char* ws; int l; const float *qg, *kg, *krg; float qscale;
    __device__ __forceinline__ void operator()(f32x4 (&acc)[2][2][4][2], const pg8::Unit& u, int wr, int wc, int fr, int fq) const {
        const int row0 = u.pm * 256 + wr * 64 + fr;
        bf16_t* qna = (bf16_t*)(ws + WS_QNA); bf16_t* kna = (bf16_t*)(ws + WS_KNA); bf16_t* vna = (bf16_t*)(ws + WS_VNA); bf16_t* P = (bf16_t*)(ws + WS_P); bf16_t* KR = (bf16_t*)(ws + WS_KR);
        const float* ssq = (const float*)(ws + WS_SSQ) + (size_t)(2 * l) * M; const float* bias = (const float*)(ws + WS_BIASIN) + (size_t)l * 4 * N_IN;
        float* ssq_cq = (float*)(ws + WS_SSQ2) + (size_t)(2 * l) * M; float* ssq_ckv = ssq_cq + M;
        const float* cosT = (const float*)(ws + WS_COS); const float* sinT = (const float*)(ws + WS_SIN);
        epi_apply_norm(acc, row0, u.pn * 256 + wc * 32 + fq * 8, ssq, bias + (size_t)(u.pm >> 5) * N_IN);
        bf16_t* dst; int ld = 256; bool norm = false; const float* g = qg; float scl = 1.f;
        if (u.pn == 0) { dst = qna + wc * 64; norm = true; scl = qscale; }
        else if (u.pn == 1) { dst = kna + wc * 64; norm = true; g = kg; }
        else if (u.pn == 2) { dst = vna + wc * 64; }
        else { dst = P + (u.pn - 3) * 256 + wc * 64; ld = 1536; }
        epi_store_heads(acc, row0, fq, norm, g, scl, dst, ld);
        if (u.pn >= 3 && u.pn <= 5) {
            const bool is_cq = (u.pn == 3) || (u.pn == 4 && wc < 2);
            if (is_cq || u.pn == 5) {
                float* sd = is_cq ? ssq_cq : ssq_ckv;
#pragma unroll
                for (int ai = 0; ai < 2; ++ai)
#pragma unroll
                    for (int m = 0; m < 4; ++m) { float ss = 0.f;
#pragma unroll
                        for (int bj = 0; bj < 2; ++bj)
#pragma unroll
                            for (int n = 0; n < 2; ++n) { const f32x4 v = acc[ai][bj][m][n]; ss += (v[0] * v[0] + v[1] * v[1]) + (v[2] * v[2] + v[3] * v[3]); }
                        ss = sum_fq(ss);
                        if (fq == 0) atomicAdd(sd + row0 + ai * 128 + m * 16, ss); }
            } else if (wc == 2) {
                const f32x4 ga = *(const f32x4*)(krg + 8 * fq), gb = *(const f32x4*)(krg + 8 * fq + 4);
#pragma unroll
                for (int ai = 0; ai < 2; ++ai)
#pragma unroll
                    for (int m = 0; m < 4; ++m) { const size_t row = (size_t)(row0 + ai * 128 + m * 16);
                        const f32x4 x0 = acc[ai][0][m][0], x1 = acc[ai][0][m][1];
                        float ss = (x0[0] * x0[0] + x0[1] * x0[1]) + (x0[2] * x0[2] + x0[3] * x0[3]) + (x1[0] * x1[0] + x1[1] * x1[1]) + (x1[2] * x1[2] + x1[3] * x1[3]);
                        ss = sum_fq(ss);
                        const float r = rsqrtf(ss * (1.f / 32.f) + EPS);
                        const f32x4 y0 = x0 * r * ga, y1 = x1 * r * gb;
                        f32x4 q0, q1;
#pragma unroll
                        for (int i = 0; i < 4; ++i) { q0[i] = other_half(y0[i]); q1[i] = other_half(y1[i]); }
                        const f32x4 c0 = *(const f32x4*)(cosT + row * 16 + 8 * (fq & 1)), c1 = *(const f32x4*)(cosT + row * 16 + 8 * (fq & 1) + 4);
                        const f32x4 s0 = *(const f32x4*)(sinT + row * 16 + 8 * (fq & 1)), s1 = *(const f32x4*)(sinT + row * 16 + 8 * (fq & 1) + 4);
                        const f32x4 o0 = (fq < 2) ? y0 * c0 - q0 * s0 : y0 * c0 + q0 * s0, o1 = (fq < 2) ? y1 * c1 - q1 * s1 : y1 * c1 + q1 * s1;
                        u32x4 w; w.x = pg8::cvt_pk_bf16(o0[0], o0[1]); w.y = pg8::cvt_pk_bf16(o0[2], o0[3]); w.z = pg8::cvt_pk_bf16(o1[0], o1[1]); w.w = pg8::cvt_pk_bf16(o1[2], o1[3]);
                        *(u32x4*)(KR + row * 32 + 8 * fq) = w; }
            }
        }
    }
};
struct EpiHeads {
    static constexpr bool PERM = true, AFTER_DRAIN = false;
    bf16_t *A, *B; const float* g; const float* ssq; float scl, invk; int ldB, pad_;
    __device__ __forceinline__ void operator()(const f32x4 (&acc)[2][2][4][2], const pg8::Unit& u, int wr, int wc, int fr, int fq) const {
        const int row0 = u.pm * 256 + wr * 64 + fr;
        const bool norm = u.pn < 2;
        bf16_t* dst = norm ? A + (4 * u.pn + wc) * 64 : B + (4 * (u.pn - 2) + wc) * 64;
        epi_store_heads(acc, row0, fq, norm, g, scl, dst, norm ? 512 : ldB, ssq, invk);
    }
};
struct EpiRes {
    static constexpr bool PERM = true, AFTER_DRAIN = false;
    const float* xin; float* xout; const float* gate;
    bf16_t* hn; const float* an; float* ssqn;
    __device__ __forceinline__ void operator()(const f32x4 (&acc)[2][2][4][2], const pg8::Unit& u, int wr, int wc, int fr, int fq) const {
        const int row0 = u.pm * 256 + wr * 64 + fr;
        const float* gp = gate + (size_t)(u.pm >> 5) * NMOD;
        float sq[2][4];
#pragma unroll
        for (int ai = 0; ai < 2; ++ai)
#pragma unroll
            for (int m = 0; m < 4; ++m) sq[ai][m] = 0.f;
#pragma unroll
        for (int bj = 0; bj < 2; ++bj) {
            const int col = u.pn * 256 + wc * 64 + bj * 32 + fq * 8;
            const f32x4 gv0 = *(const f32x4*)(gp + col), gv1 = *(const f32x4*)(gp + col + 4);
            f32x4 av0 = {0.f, 0.f, 0.f, 0.f}, av1 = av0; if (hn) { av0 = *(const f32x4*)(an + (size_t)(u.pm >> 5) * D + col); av1 = *(const f32x4*)(an + (size_t)(u.pm >> 5) * D + col + 4); }
#pragma unroll
            for (int ai = 0; ai < 2; ++ai)
#pragma unroll
                for (int m = 0; m < 4; ++m) { const size_t off = (size_t)(row0 + ai * 128 + m * 16) * D + col;
                    const f32x4 x0 = *(const f32x4*)(xin + off) + gv0 * acc[ai][bj][m][0], x1 = *(const f32x4*)(xin + off + 4) + gv1 * acc[ai][bj][m][1];
                    *(f32x4*)(xout + off) = x0; *(f32x4*)(xout + off + 4) = x1;
                    if (hn) { const f32x4 h0 = x0 * av0, h1 = x1 * av1; u32x4 w; w.x = pg8::cvt_pk_bf16(h0[0], h0[1]); w.y = pg8::cvt_pk_bf16(h0[2], h0[3]); w.z = pg8::cvt_pk_bf16(h1[0], h1[1]); w.w = pg8::cvt_pk_bf16(h1[2], h1[3]);
                        *(u32x4*)(hn + off) = w;
                        sq[ai][m] += (x0[0] * x0[0] + x0[1] * x0[1]) + (x0[2] * x0[2] + x0[3] * x0[3]) + (x1[0] * x1[0] + x1[1] * x1[1]) + (x1[2] * x1[2] + x1[3] * x1[3]); } }
        }
        if (hn) {
#pragma unroll
            for (int ai = 0; ai < 2; ++ai)
#pragma unroll
                for (int m = 0; m < 4; ++m) { float s = sq[ai][m]; s = sum_fq(s);
                    if (fq == 0) atomicAdd(ssqn + row0 + ai * 128 + m * 16, s); }
        }
    }
};
__device__ __forceinline__ float silu_f(float x) { return x * __builtin_amdgcn_rcpf(1.f + __builtin_amdgcn_exp2f(-x * LOG2E)); }
struct EpiGU {
    static constexpr bool PERM = true, AFTER_DRAIN = false;
    bf16_t* act; const float *ssq, *bias;
    __device__ __forceinline__ void operator()(f32x4 (&acc)[2][2][4][2], const pg8::Unit& u, int wr, int wc, int fr, int fq) const {
        const int row0 = u.pm * 256 + wr * 64 + fr;
        epi_apply_norm(acc, row0, u.pn * 256 + wc * 32 + fq * 8, ssq, bias + (size_t)(u.pm >> 5) * N_GU);
#pragma unroll
        for (int ai = 0; ai < 2; ++ai)
#pragma unroll
            for (int m = 0; m < 4; ++m) {
                bf16_t* rowp = act + (size_t)(row0 + ai * 128 + m * 16) * DFF + u.pn * 128 + wc * 32 + fq * 8;
                float v[8];
#pragma unroll
                for (int n = 0; n < 2; ++n)
#pragma unroll
                    for (int i = 0; i < 4; ++i) v[4 * n + i] = silu_f(acc[ai][0][m][n][i]) * acc[ai][1][m][n][i];
                u32x4 w; w.x = pg8::cvt_pk_bf16(v[0], v[1]); w.y = pg8::cvt_pk_bf16(v[2], v[3]); w.z = pg8::cvt_pk_bf16(v[4], v[5]); w.w = pg8::cvt_pk_bf16(v[6], v[7]);
                *(u32x4*)rowp = w;
            }
    }
};

namespace att {
typedef short bf16x8 __attribute__((ext_vector_type(8)));
typedef short s16x4 __attribute__((ext_vector_type(4)));
typedef float f32x16 __attribute__((ext_vector_type(16)));
constexpr int KBUF = 64 * 208, OFF_K = 0, OFF_V = 2 * KBUF, OFF_BIAS = OFF_V + 2 * 8192, OFF_OST = 49152;
__device__ __forceinline__ s16x4 vtr(const LAS unsigned char* p) { return __builtin_bit_cast(s16x4, __builtin_amdgcn_ds_read_tr16_b64_v4i16((LAS s16x4*)p)); }
__device__ __forceinline__ float half_max(float m) { auto rr = __builtin_amdgcn_permlane32_swap(__float_as_uint(m), __float_as_uint(m), false, false); return fmaxf(__uint_as_float(rr[0]), __uint_as_float(rr[1])); }
__device__ __forceinline__ float half_sum(float m) { auto rr = __builtin_amdgcn_permlane32_swap(__float_as_uint(m), __float_as_uint(m), false, false); return __uint_as_float(rr[0]) + __uint_as_float(rr[1]); }

template <bool NA>
__device__ __forceinline__ void attn_unit(LAS unsigned char* lds, int b, int h, int ublk,
        const bf16_t* __restrict__ Qa, int ldq, const bf16_t* __restrict__ Qb,
        const bf16_t* __restrict__ Ka, int ldk, const bf16_t* __restrict__ Kb,
        const bf16_t* __restrict__ Vg, int ldv,
        const float* __restrict__ rpb, const float* __restrict__ og, bf16_t* __restrict__ outp,
        const float* __restrict__ cosT, const float* __restrict__ sinT, const float* __restrict__ qrg, float qrs,
        const float* __restrict__ kgn1, const float* __restrict__ kgn2) {
    constexpr int NDS = NA ? 4 : 6, KSTR = NA ? 144 : 208;
    int tid_ = threadIdx.x; asm volatile("" : "+v"(tid_));
    const int tid = tid_, lane = tid & 63, wid = __builtin_amdgcn_readfirstlane(tid >> 6), r32 = lane & 31, hi = lane >> 5;
    int t_lo, t_hi, w_lo, w_hi, qc = 0, cs = 0, R = 0; size_t tokq;
    if (NA) { const int R0 = 4 * ublk; R = R0 + (wid >> 1); qc = 32 * (wid & 1) + r32;
        t_lo = min(max(R0 - 4, 0), 120); t_hi = min(max(R0 - 1, 0), 120) + 8; w_lo = min(max(R - 4, 0), 120); w_hi = w_lo + 8;
        cs = min(max(qc - 8, 0), 48); tokq = (size_t)b * T + R * 64 + qc; }
    else { t_lo = 0; t_hi = T / 64; w_lo = 0; w_hi = T / 64; tokq = (size_t)b * T + ublk * 256 + wid * 32 + r32; }
    constexpr int SPR = KSTR / 16, DCH = NA ? 8 : 12;
    const bool has_k1 = wid + 8 < SPR;
    const bf16_t *ks0, *ks1, *vs0; size_t kst0, kst1;
#define ATT_KSRC(PIECE, SRC, STEP) do { const int s_ = 64 * (PIECE) + lane, row_ = s_ / SPR, c_ = s_ - row_ * SPR, cc_ = (c_ == DCH) ? 0 : c_; \
        if (NA || cc_ < 8) { SRC = Ka + ((size_t)b * T + row_) * ldk + h * 64 + cc_ * 8; STEP = (size_t)64 * ldk; } \
        else { SRC = Kb + ((size_t)b * T + row_) * 32 + (cc_ - 8) * 8; STEP = (size_t)64 * 32; } } while (0)
    ATT_KSRC(wid, ks0, kst0);
    ATT_KSRC(has_k1 ? wid + 8 : wid, ks1, kst1);
#undef ATT_KSRC
    { const int s_ = 64 * wid + lane, dh_ = s_ >> 8, row_ = (s_ >> 2) & 63, c3_ = s_ & 3; vs0 = Vg + ((size_t)b * T + row_) * ldv + h * 64 + (dh_ * 4 + c3_) * 8; }
#define ATT_DMA(TILE, BUF) do { \
        __builtin_amdgcn_global_load_lds((const unsigned*)(ks0 + (size_t)(TILE) * kst0), (LAS unsigned*)(lds + OFF_K + (BUF) * KBUF + wid * 1024), 16, 0, 0); \
        if (has_k1) __builtin_amdgcn_global_load_lds((const unsigned*)(ks1 + (size_t)(TILE) * kst1), (LAS unsigned*)(lds + OFF_K + (BUF) * KBUF + (wid + 8) * 1024), 16, 0, 0); \
        __builtin_amdgcn_global_load_lds((const unsigned*)(vs0 + (size_t)(TILE) * 64 * ldv), (LAS unsigned*)(lds + OFF_V + (BUF) * 8192 + wid * 1024), 16, 0, 0); } while (0)
    ATT_DMA(t_lo, 0);
    bf16x8 qf[NDS];
    { const bf16_t* qp = Qa + tokq * ldq + h * 64 + hi * 8;
#pragma unroll
      for (int ds = 0; ds < 4; ++ds) qf[ds] = *(const bf16x8*)(qp + ds * 16);
      if (!NA) { const bf16_t* qp2 = Qb + tokq * 256 + h * 32 + hi * 8;
          const u32x4 ua = *(const u32x4*)qp2, ub = *(const u32x4*)(qp2 + 16);
          float x1[8], x2[8]; float ss = 0.f;
#pragma unroll
          for (int i = 0; i < 4; ++i) { x1[2 * i] = bf_lo(ua[i]); x1[2 * i + 1] = bf_hi(ua[i]); x2[2 * i] = bf_lo(ub[i]); x2[2 * i + 1] = bf_hi(ub[i]); }
#pragma unroll
          for (int i = 0; i < 8; ++i) ss += x1[i] * x1[i] + x2[i] * x2[i];
          const float rs = rsqrtf(half_sum(ss) * (1.f / 32.f) + EPS) * qrs;
          u32x4 wa, wb;
#pragma unroll
          for (int i = 0; i < 4; ++i) {
              float o1[2], o2[2];
#pragma unroll
              for (int j = 0; j < 2; ++j) { const int e = 8 * hi + 2 * i + j; const float cc = cosT[tokq * 16 + e], sn = sinT[tokq * 16 + e];
                  const float y1 = x1[2 * i + j] * rs * qrg[e], y2 = x2[2 * i + j] * rs * qrg[16 + e];
                  o1[j] = y1 * cc - y2 * sn; o2[j] = y2 * cc + y1 * sn; }
              wa[i] = pg8::cvt_pk_bf16(o1[0], o1[1]); wb[i] = pg8::cvt_pk_bf16(o2[0], o2[1]); }
          qf[NDS - 2] = __builtin_bit_cast(bf16x8, wa); qf[NDS - 1] = __builtin_bit_cast(bf16x8, wb); } }
    if (NA) { if (tid < 480) { const int dr = tid >> 5, dc = tid & 31; ((LAS float*)(lds + OFF_BIAS))[tid] = dc < 31 ? rpb[dr * 31 + dc] * LOG2E : 0.f; } }
    float mref;
    { float qn2 = 0.f;
#pragma unroll
      for (int ds = 0; ds < NDS; ++ds) { const u32x4 u = __builtin_bit_cast(u32x4, qf[ds]);
#pragma unroll
          for (int i = 0; i < 4; ++i) { const float a = bf_lo(u[i]), bq = bf_hi(u[i]); qn2 += a * a + bq * bq; } }
      qn2 = half_sum(qn2);
      float g1 = kgn1[lane]; g1 *= g1;
      float g2 = 0.f; if (!NA) { g2 = kgn2[lane & 31]; g2 *= g2; }
      float bm = 0.f; if (NA) { for (int i = lane; i < 15 * 31; i += 64) bm = fmaxf(bm, rpb[i]); }
      g1 = wave_max(g1); g2 = wave_max(g2); if (NA) bm = wave_max(bm);
      mref = sqrtf(qn2 * (64.f * g1 + 32.f * g2)) * 1.02f + 1.f + bm * LOG2E; }
    f32x16 negm;
#pragma unroll
    for (int r = 0; r < 16; ++r) negm[r] = -mref;
    __syncthreads();
    float l_run = 0.f;
    f32x16 o0 = {}, o1 = {};
    const int pim = (r32 & 0x13) | ((r32 & 4) << 1) | ((r32 & 8) >> 1);
    const int koff = pim * KSTR + hi * 16;
    const int voff = (8 * hi + ((lane & 15) >> 2)) * 64 + (16 * ((lane >> 4) & 1) + 4 * (lane & 3)) * 2;
    for (int t = t_lo; t < t_hi; ++t) {
        const int cur = (t - t_lo) & 1;
        const bool more = t + 1 < t_hi;
        if (NA) { if (more) ATT_DMA(t + 1, cur ^ 1); }
        if (t >= w_lo && t < w_hi) {
            const LAS unsigned char* a0 = lds + OFF_K + cur * KBUF + koff;
            f32x16 p0, p1;
            bf16x8 kf[2 * NDS];
#pragma unroll
            for (int ds = 0; ds < NDS; ++ds) { kf[2 * ds] = *(const LAS bf16x8*)(a0 + ds * 32); kf[2 * ds + 1] = *(const LAS bf16x8*)(a0 + 32 * KSTR + ds * 32); }
            __builtin_amdgcn_sched_barrier(0);
#pragma unroll
            for (int ds = 0; ds < NDS; ++ds) {
                if (ds == 0) { p0 = __builtin_amdgcn_mfma_f32_32x32x16_bf16(kf[0], qf[0], negm, 0, 0, 0); p1 = __builtin_amdgcn_mfma_f32_32x32x16_bf16(kf[1], qf[0], negm, 0, 0, 0); }
                else { p0 = __builtin_amdgcn_mfma_f32_32x32x16_bf16(kf[2 * ds], qf[ds], p0, 0, 0, 0); p1 = __builtin_amdgcn_mfma_f32_32x32x16_bf16(kf[2 * ds + 1], qf[ds], p1, 0, 0, 0); }
            }
            const LAS unsigned char* va = lds + OFF_V + cur * 8192 + voff;
            s16x4 vl0[4], vh0[4], vl1[4], vh1[4];
#pragma unroll
            for (int s = 0; s < 4; ++s) { vl0[s] = vtr(va + s * 1024); vh0[s] = vtr(va + s * 1024 + 256); vl1[s] = vtr(va + 4096 + s * 1024); vh1[s] = vtr(va + 4096 + s * 1024 + 256); }
            __builtin_amdgcn_sched_barrier(0);
            if (!NA) { if (more) ATT_DMA(t + 1, cur ^ 1); __builtin_amdgcn_sched_barrier(0); }
            if (NA) {
                const LAS float* bt = (const LAS float*)(lds + OFF_BIAS) + (t - R + 7) * 32;
#pragma unroll
                for (int r = 0; r < 16; ++r) {
                    const int kc0 = 16 * (r >> 3) + 8 * hi + (r & 7), kc1 = kc0 + 32;
                    const int i0 = min(max(kc0 - qc + 15, 0), 30), i1 = min(max(kc1 - qc + 15, 0), 30);
                    p0[r] = ((unsigned)(kc0 - cs) < 16u) ? p0[r] + bt[i0] : -1e30f;
                    p1[r] = ((unsigned)(kc1 - cs) < 16u) ? p1[r] + bt[i1] : -1e30f;
                }
            }
            float ps0 = 0.f, ps1 = 0.f;
#pragma unroll
            for (int r = 0; r < 16; ++r) { p0[r] = __builtin_amdgcn_exp2f(p0[r]); p1[r] = __builtin_amdgcn_exp2f(p1[r]); ps0 += p0[r]; ps1 += p1[r]; }
            l_run += ps0 + ps1;
            bf16x8 pb[4];
#pragma unroll
            for (int s = 0; s < 4; ++s) { const int bs = 8 * (s & 1); u32x4 w;
                if (s < 2) { w.x = pg8::cvt_pk_bf16(p0[bs], p0[bs + 1]); w.y = pg8::cvt_pk_bf16(p0[bs + 2], p0[bs + 3]); w.z = pg8::cvt_pk_bf16(p0[bs + 4], p0[bs + 5]); w.w = pg8::cvt_pk_bf16(p0[bs + 6], p0[bs + 7]); }
                else { w.x = pg8::cvt_pk_bf16(p1[bs], p1[bs + 1]); w.y = pg8::cvt_pk_bf16(p1[bs + 2], p1[bs + 3]); w.z = pg8::cvt_pk_bf16(p1[bs + 4], p1[bs + 5]); w.w = pg8::cvt_pk_bf16(p1[bs + 6], p1[bs + 7]); }
                pb[s] = __builtin_bit_cast(bf16x8, w); }
#pragma unroll
            for (int s = 0; s < 4; ++s) {
                const bf16x8 vf0 = {vl0[s][0], vl0[s][1], vl0[s][2], vl0[s][3], vh0[s][0], vh0[s][1], vh0[s][2], vh0[s][3]}, vf1 = {vl1[s][0], vl1[s][1], vl1[s][2], vl1[s][3], vh1[s][0], vh1[s][1], vh1[s][2], vh1[s][3]};
                o0 = __builtin_amdgcn_mfma_f32_32x32x16_bf16(vf0, pb[s], o0, 0, 0, 0);
                o1 = __builtin_amdgcn_mfma_f32_32x32x16_bf16(vf1, pb[s], o1, 0, 0, 0);
            }
        }
        __syncthreads();
    }
#undef ATT_DMA
    const float inv = 1.f / half_sum(l_run);
    float ss = 0.f;
#pragma unroll
    for (int r = 0; r < 16; ++r) { o0[r] *= inv; o1[r] *= inv; ss += o0[r] * o0[r] + o1[r] * o1[r]; }
    ss = half_sum(ss);
    const float rn = rsqrtf(ss * (1.f / 64.f) + EPS);
    LAS unsigned char* stg = lds + OFF_OST + wid * 4608;
#pragma unroll
    for (int rq = 0; rq < 4; ++rq) {
        const int d0 = 8 * rq + 4 * hi;
        const f32x4 g0 = *(const f32x4*)(og + d0), g1 = *(const f32x4*)(og + 32 + d0);
        u32x2 w0, w1;
        w0.x = pg8::cvt_pk_bf16(o0[4 * rq] * rn * g0[0], o0[4 * rq + 1] * rn * g0[1]); w0.y = pg8::cvt_pk_bf16(o0[4 * rq + 2] * rn * g0[2], o0[4 * rq + 3] * rn * g0[3]);
        w1.x = pg8::cvt_pk_bf16(o1[4 * rq] * rn * g1[0], o1[4 * rq + 1] * rn * g1[1]); w1.y = pg8::cvt_pk_bf16(o1[4 * rq + 2] * rn * g1[2], o1[4 * rq + 3] * rn * g1[3]);
        *(LAS u32x2*)(stg + r32 * 144 + d0 * 2) = w0; *(LAS u32x2*)(stg + r32 * 144 + (32 + d0) * 2) = w1;
    }
    LDS_WAIT();
    bf16_t* ob = outp + (tokq - r32) * 1024;
#pragma unroll
    for (int i = 0; i < 4; ++i) { const int row = i * 8 + (lane >> 3), ch = lane & 7;
        const u32x4 v = *(const LAS u32x4*)(stg + row * 144 + ch * 16);
        *(u32x4*)(ob + (size_t)row * 1024 + ch * 8) = v; }
    LDS_WAIT();
}
}

#define XB_TMO      128
#define XB_XCNT(j)  (256  + 64 * (j))
#define XB_XSUB(j)  (1280 + 64 * (j))
#define XB_XGEN(j)  (2304 + 64 * (j))
#define XB_TOP      3328
#define XB_TOPGEN   3392
#define XCD_BAR_WORDS 3456
#define XB_SPIN_CAP (1u << 18)

__device__ __forceinline__ unsigned xb_ld(unsigned* p)              { return __hip_atomic_load(p, __ATOMIC_RELAXED, __HIP_MEMORY_SCOPE_AGENT); }
__device__ __forceinline__ unsigned xb_add(unsigned* p, unsigned v) { return __hip_atomic_fetch_add(p, v, __ATOMIC_RELAXED, __HIP_MEMORY_SCOPE_AGENT); }
__device__ __forceinline__ unsigned xb_xcc_id() { return (unsigned)__builtin_amdgcn_s_getreg((3 << 11) | 20) & 0xFu; }
#define XB_SPIN(cond, bar) do { unsigned _sp = 0; while (cond) { __builtin_amdgcn_s_sleep(1); \
    if ((++_sp & 255u) == 0u) { if (xb_ld(&(bar)[XB_TMO])) break; if (_sp > XB_SPIN_CAP) { atomicAdd(&(bar)[XB_TMO], 1u); break; } } } } while (0)

struct XcdBarrier {
    unsigned* bar; unsigned x;
    volatile LAS unsigned* st;
};

__device__ __forceinline__ XcdBarrier xcd_barrier_post(unsigned* bar, volatile LAS unsigned* st) {
    XcdBarrier b; b.bar = bar; b.x = xb_xcc_id(); b.st = st;
    if (threadIdx.x == 0) (void)xb_add(&bar[XB_XCNT(b.x)], 1u);
    return b;
}
__device__ __forceinline__ void xcd_barrier_complete(unsigned* bar, unsigned x, unsigned& nloc, unsigned& nx) {
    const unsigned G = gridDim.x * gridDim.y * gridDim.z;
    unsigned sum, cnt, mine, sp = 0u;
    for (;;) {
        sum = 0u; cnt = 0u; mine = 0u;
#pragma unroll
        for (unsigned j = 0; j < 16; ++j) { const unsigned c = xb_ld(&bar[XB_XCNT(j)]); sum += c; cnt += (c > 0u) ? 1u : 0u; mine = (j == x) ? c : mine; }
        if (sum == G) break;
        __builtin_amdgcn_s_sleep(1);
        if ((++sp & 255u) == 0u) { if (xb_ld(&bar[XB_TMO])) break; if (sp > XB_SPIN_CAP) { atomicAdd(&bar[XB_TMO], 1u); break; } }
    }
    nloc = mine > 0u ? mine : 1u; nx = cnt > 0u ? cnt : 1u;
}

__device__ __forceinline__ void xcd_barrier(const XcdBarrier& b) {
    asm volatile("s_waitcnt vmcnt(0)" ::: "memory");
    __syncthreads();
    if (threadIdx.x == 0) {
        unsigned* bar = b.bar;
        __builtin_amdgcn_s_waitcnt(0);
        unsigned nloc = b.st[0], nx = b.st[1];
        if (nloc == 0u) { xcd_barrier_complete(bar, b.x, nloc, nx); b.st[0] = nloc; b.st[1] = nx; }
        const unsigned old = xb_add(&bar[XB_XSUB(b.x)], 1u);
        const unsigned gen = old / nloc;
        if (old + 1u == (gen + 1u) * nloc) {
            __builtin_amdgcn_fence(__ATOMIC_RELEASE, "agent");
            asm volatile("s_waitcnt vmcnt(0)" ::: "memory");
            const unsigned og = xb_add(&bar[XB_TOP], 1u);
            const unsigned tg = og / nx;
            if (og + 1u == (tg + 1u) * nx) xb_add(&bar[XB_TOPGEN], 1u);
            else XB_SPIN(xb_ld(&bar[XB_TOPGEN]) == tg, bar);
            __builtin_amdgcn_fence(__ATOMIC_ACQUIRE, "agent");
            xb_add(&bar[XB_XGEN(b.x)], 1u);
            asm volatile("s_waitcnt vmcnt(0)" ::: "memory");
        } else {
            XB_SPIN(xb_ld(&bar[XB_XGEN(b.x)]) == gen, bar);
            __builtin_amdgcn_fence(__ATOMIC_ACQUIRE, "agent");
            asm volatile("s_waitcnt vmcnt(0)" ::: "memory");
        }
    }
    __syncthreads();
}

struct Params {
    const float* in[25]; float* out; unsigned char* ws;
    int ph_lo, ph_hi, coop, pad;
    float inv_freq[16];
};
constexpr int NPHASES = 1 + 9 * DEPTH;
constexpr int LDS_BYTES = 131072 + 1024;

__global__ void __launch_bounds__(NTHREADS) fwd_kernel(Params p) {
    extern __shared__ __attribute__((aligned(16))) unsigned char lds_raw[];
    LAS unsigned char* lds = (LAS unsigned char*)lds_raw;
    const int G = gridDim.x, bid = blockIdx.x;
#define PHASE_IDS() int tid = threadIdx.x; asm volatile("" : "+v"(tid)); const int lane = tid & 63, wave = __builtin_amdgcn_readfirstlane(tid >> 6); const int gw = bid * NWAVES + wave; (void)gw; (void)lane
    const int vcu = (G % 8 == 0) ? (bid % 8) * (G / 8) + bid / 8 : bid;
    const int NGW = G * NWAVES;
    unsigned char* ws = p.ws;
    const float* x0 = p.in[0]; const float* cvec = p.in[1]; const int* pos = (const int*)p.in[2];
    float* mod = (float*)(ws + WS_MOD); float* cosT = (float*)(ws + WS_COS); float* sinT = (float*)(ws + WS_SIN);
    bf16_t* H = (bf16_t*)(ws + WS_H); bf16_t* Vb = (bf16_t*)(ws + WS_V); float* SSQ2 = (float*)(ws + WS_SSQ2);
    float* XA = (float*)(ws + WS_XA);
    float* SSQ = (float*)(ws + WS_SSQ); float* BIASIN = (float*)(ws + WS_BIASIN); float* BIASGU = (float*)(ws + WS_BIASGU); float* AVEC = (float*)(ws + WS_AVEC);
    bf16_t* QNA = (bf16_t*)(ws + WS_QNA); bf16_t* KNA = (bf16_t*)(ws + WS_KNA); bf16_t* VNA = (bf16_t*)(ws + WS_VNA);
    bf16_t* P = (bf16_t*)(ws + WS_P); bf16_t* QN = (bf16_t*)(ws + WS_QN); bf16_t* KN = (bf16_t*)(ws + WS_KN); bf16_t* QR = (bf16_t*)(ws + WS_QR);
    bf16_t* KR = (bf16_t*)(ws + WS_KR); bf16_t* MIX = (bf16_t*)(ws + WS_MIX); bf16_t* ACT = (bf16_t*)(ws + WS_ACT);
    cg::grid_group grid = cg::this_grid();
    const int lo = p.ph_lo, hi = p.ph_hi;
#ifndef REP_P0
#define REP_P0 0
#endif
#ifndef REP_MASK
#define REP_MASK 0
#endif
#ifndef PH_MASK
#define PH_MASK 0x3ff
#endif
#define IN_PH(k) (lo <= (k) && (k) < hi)
#define IN_PHL(c) (((PH_MASK >> ((c) + 1)) & 1) && lo <= (pb + (c)) && (pb + (c)) < hi)
#define SEAM(k) do { if (IN_PH(k) && IN_PH((k) + 1)) xcd_barrier(xbar); } while (0)
    LAS unsigned* misc = (LAS unsigned*)(lds + 131072);
    unsigned* barw = (unsigned*)(ws + WS_BAR);
    if (threadIdx.x < 16) misc[threadIdx.x] = 0u;
    if (p.coop && bid == 0) for (int i = threadIdx.x; i < XCD_BAR_WORDS; i += NTHREADS) __hip_atomic_store(barw + i, 0u, __ATOMIC_RELAXED, __HIP_MEMORY_SCOPE_AGENT);
    __syncthreads();
    XcdBarrier xbar; xbar.bar = barw; xbar.x = 0; xbar.st = (volatile LAS unsigned*)misc;

    if ((PH_MASK & 1) && IN_PH(0)) for (int rep0_ = 0; rep0_ <= REP_P0; ++rep0_) {
        PHASE_IDS();
        { LAS float* red = (LAS float*)lds; LAS float* sc = (LAS float*)(lds + 8192);
          for (int i = tid; i < 4 * D; i += NTHREADS) { const float cv = cvec[i]; sc[i] = cv / (1.f + __expf(-cv)); }
          __syncthreads();
          for (int item = bid; item < 2 * NMOD / 64; item += G) {
            const int col = item * 64 + lane, l = col / NMOD, j = col % NMOD;
            const float* wp = p.in[5] + ((size_t)l * D + wave * 128) * NMOD + j;
            const LAS float* scw = sc + wave * 128;
            float a0 = 0.f, a1 = 0.f, a2 = 0.f, a3 = 0.f;
#pragma unroll 1
            for (int k0 = 0; k0 < 128; k0 += 32) { float w[32];
#pragma unroll
                for (int k = 0; k < 32; ++k) w[k] = wp[(size_t)(k0 + k) * NMOD];
#pragma unroll
                for (int k = 0; k < 32; ++k) { a0 += scw[k0 + k] * w[k]; a1 += scw[D + k0 + k] * w[k]; a2 += scw[2 * D + k0 + k] * w[k]; a3 += scw[3 * D + k0 + k] * w[k]; } }
            red[(wave * 4 + 0) * 64 + lane] = a0; red[(wave * 4 + 1) * 64 + lane] = a1; red[(wave * 4 + 2) * 64 + lane] = a2; red[(wave * 4 + 3) * 64 + lane] = a3;
            __syncthreads();
            if (wave < 4) { float s = p.in[6][(size_t)l * NMOD + j];
#pragma unroll
                for (int kc = 0; kc < 8; ++kc) s += red[(kc * 4 + wave) * 64 + lane];
                mod[((size_t)l * 4 + wave) * NMOD + j] = s; }
            __syncthreads();
          } }
        for (int i = bid * NTHREADS + tid; i < 3 * M; i += G * NTHREADS) SSQ[M + i] = 0.f;
        for (int i = bid * NTHREADS + tid; i < 4 * M; i += G * NTHREADS) SSQ2[i] = 0.f;
        for (int i = bid * NTHREADS + tid; i < M * 16; i += G * NTHREADS) {
            const int row = i >> 4, e = i & 15;
            const float ang = (float)pos[row] * p.inv_freq[e];
            double rev = (double)ang * 0.15915494309189535; rev -= rint(rev);
            const float fr = (float)rev;
            cosT[i] = __builtin_amdgcn_cosf(fr); sinT[i] = __builtin_amdgcn_sinf(fr);
        }
        { LAS float* scr = (LAS float*)(lds + wave * 16384);
          constexpr int I0 = (N_IN / 32) * (D / 64), I1 = (N_UQ / 32) * (K_UQ / 64), I2 = (N_UKV / 32) * (K_UKV / 64), I3 = (D / 32) * (D / 64), I4 = (N_GU / 32) * (D / 64), I5 = (D / 32) * (DFF / 64);
          constexpr int IPL = I0 + I1 + I2 + I3 + I4 + I5;
          for (int it = gw; it < DEPTH * IPL; it += NGW) {
            const int l = it / IPL; int r = it % IPL;
            bf16_t* wl = (bf16_t*)(ws + WS_W + (size_t)l * W_LAYER);
            if (r < I0) { transpose_item(p.in[7] + (size_t)l * D * D_IN, D, D_IN, 0, (bf16_t*)((unsigned char*)wl + WO_IN), scr, r, N_IN / 32, lane); continue; } r -= I0;
            if (r < I1) { transpose_item(p.in[13] + (size_t)l * K_UQ * N_UQ, K_UQ, N_UQ, 1, (bf16_t*)((unsigned char*)wl + WO_UQ), scr, r, N_UQ / 32, lane, p.in[11] + (size_t)l * K_UQ); continue; } r -= I1;
            if (r < I2) { transpose_item(p.in[14] + (size_t)l * K_UKV * N_UKV, K_UKV, N_UKV, 2, (bf16_t*)((unsigned char*)wl + WO_UKV), scr, r, N_UKV / 32, lane, p.in[12] + (size_t)l * K_UKV); continue; } r -= I2;
            if (r < I3) { transpose_item(p.in[22] + (size_t)l * D * D, D, D, 3, (bf16_t*)((unsigned char*)wl + WO_OUT), scr, r, D / 32, lane); continue; } r -= I3;
            if (r < I4) { transpose_item(p.in[23] + (size_t)l * D * N_GU, D, N_GU, 4, (bf16_t*)((unsigned char*)wl + WO_GU), scr, r, N_GU / 32, lane); continue; } r -= I4;
            transpose_item(p.in[24] + (size_t)l * DFF * D, DFF, D, 5, (bf16_t*)((unsigned char*)wl + WO_DOWN), scr, r, D / 32, lane);
          } }
    }
    if (p.coop) { grid.sync(); xbar = xcd_barrier_post(barw, (volatile LAS unsigned*)misc); }

    for (int l = 0; l < DEPTH; ++l) {
        const int pb = 1 + 9 * l;
        const float* xin = (l == 0) ? x0 : p.out;
        const float* modl = mod + (size_t)l * 4 * NMOD;
        const unsigned char* wl = ws + WS_W + (size_t)l * W_LAYER;
        if (l == 0) {
        if (IN_PHL(0)) for (int rep_ = 0; rep_ <= ((REP_MASK >> 0) & 1); ++rep_) {
            PHASE_IDS();
            for (int i = bid * NTHREADS + tid; i < 2 * 2 * 4 * D; i += G * NTHREADS) {
                const int k = i & (D - 1), b = (i >> 10) & 3, which = (i >> 12) & 1, l2 = i >> 13;
                AVEC[i] = p.in[3 + which][(size_t)l2 * D + k] * (1.f + mod[((size_t)l2 * 4 + b) * NMOD + (which ? 4 : 1) * D + k]);
            }
            for (int rr = gw; rr < 2 * (N_IN + N_GU); rr += NGW) {
                const int l2 = rr / (N_IN + N_GU), r2 = rr % (N_IN + N_GU); const bool isgu = r2 >= N_IN; const int n = isgu ? r2 - N_IN : r2;
                const bf16_t* wrow = (const bf16_t*)(ws + WS_W + (size_t)l2 * W_LAYER + (isgu ? WO_GU : WO_IN)) + (size_t)n * D + 16 * lane;
                const u32x4 wa = *(const u32x4*)wrow, wb = *(const u32x4*)(wrow + 8);
                float wv[16];
#pragma unroll
                for (int i = 0; i < 4; ++i) { wv[2 * i] = bf_lo(wa[i]); wv[2 * i + 1] = bf_hi(wa[i]); wv[8 + 2 * i] = bf_lo(wb[i]); wv[8 + 2 * i + 1] = bf_hi(wb[i]); }
                float s4[4];
#pragma unroll
                for (int b = 0; b < 4; ++b) { const float* sh = mod + ((size_t)l2 * 4 + b) * NMOD + (isgu ? 3 : 0) * D + 16 * lane; float s = 0.f;
#pragma unroll
                    for (int i = 0; i < 16; ++i) s += sh[i] * wv[i];
                    s4[b] = wave_sum(s); }
                if (lane < 4) { float* bo = isgu ? BIASGU + ((size_t)l2 * 4 + lane) * N_GU + n : BIASIN + ((size_t)l2 * 4 + lane) * N_IN + n;
                    *bo = lane == 0 ? s4[0] : lane == 1 ? s4[1] : lane == 2 ? s4[2] : s4[3]; }
            }
            const float* gn = p.in[3] + (size_t)l * D;
            for (int m0 = gw * 16; m0 < M; m0 += NGW * 16) {
                const int b = m0 / T; const float* mb = modl + (size_t)b * NMOD;
                f32x4 a[4];
#pragma unroll
                for (int j = 0; j < 4; ++j) { const int cc = 4 * lane + 256 * j; a[j] = *(const f32x4*)(gn + cc) * (*(const f32x4*)(mb + D + cc) + 1.f); }
                for (int r = 0; r < 16; ++r) {
                    const f32x4* xr = (const f32x4*)(xin + (size_t)(m0 + r) * D) + lane;
                    f32x4 v[4]; float ss = 0.f;
#pragma unroll
                    for (int j = 0; j < 4; ++j) { v[j] = xr[64 * j]; ss += (v[j][0] * v[j][0] + v[j][1] * v[j][1]) + (v[j][2] * v[j][2] + v[j][3] * v[j][3]); }
                    ss = wave_sum(ss);
                    if (lane == 0) SSQ[m0 + r] = ss;
                    u32x2* o8 = (u32x2*)(H + (size_t)(m0 + r) * D) + lane;
#pragma unroll
                    for (int j = 0; j < 4; ++j) { const f32x4 o = v[j] * a[j]; u32x2 w; w.x = pg8::cvt_pk_bf16(o[0], o[1]); w.y = pg8::cvt_pk_bf16(o[2], o[3]); o8[64 * j] = w; }
                }
            }
        }
        SEAM(pb + 0);
        }
        if (IN_PHL(1)) for (int rep_ = 0; rep_ <= ((REP_MASK >> 1) & 1); ++rep_) {
            pg8::Gemm g{H, (const bf16_t*)(wl + WO_IN), M, N_IN, D, D}; pg8::StaticOrder S; S.init(M, N_IN, G, bid);
            EpiIn E{ws, l, p.in[8] + l * 64, p.in[9] + l * 64, p.in[18] + l * 32, 0.125f * LOG2E};
            pg8::gemm_phase<EpiIn, pg8::StaticOrder, true, true>(lds, g, S, E);
        }
        SEAM(pb + 1);
        if (IN_PHL(3)) for (int rep_ = 0; rep_ <= ((REP_MASK >> 3) & 1); ++rep_) {
            { PHASE_IDS();
              const float* cw = p.in[19] + (size_t)l * 3 * 256; const float* cb = p.in[20] + (size_t)l * 256; const float* ong = p.in[21] + (size_t)l * D + 768;
              const f32x4 w0 = *(const f32x4*)(cw + 4 * lane), w1 = *(const f32x4*)(cw + 256 + 4 * lane), w2 = *(const f32x4*)(cw + 512 + 4 * lane), cbv = *(const f32x4*)(cb + 4 * lane), ogv = *(const f32x4*)(ong + 4 * lane);
              for (int m0 = gw * 16; m0 < M; m0 += NGW * 16) {
#pragma unroll 1
                for (int hb = 0; hb < 2; ++hb) {
                    const int mb0 = m0 + 8 * hb, tb0 = mb0 % T, seq0 = mb0 - tb0;
                    u32x2 xi[10], gc[10], gbu[8];
#pragma unroll
                    for (int i = 0; i < 10; ++i) { const int tt = min(max(tb0 - 1 + i, 0), T - 1); const bf16_t* q = P + (size_t)(seq0 + tt) * 1536;
                        xi[i] = *(const u32x2*)(q + 768 + 4 * lane); gc[i] = *(const u32x2*)(q + 1280 + 4 * lane); }
#pragma unroll
                    for (int r = 0; r < 8; ++r) gbu[r] = *(const u32x2*)(P + (size_t)(mb0 + r) * 1536 + 1024 + 4 * lane);
                    f32x4 uu[10];
#pragma unroll
                    for (int i = 0; i < 10; ++i) { const int tt = tb0 - 1 + i; const float mk = (tt >= 0 && tt < T) ? 1.f : 0.f;
                        uu[i] = (f32x4){bf_lo(xi[i].x) * bf_lo(gc[i].x), bf_hi(xi[i].x) * bf_hi(gc[i].x), bf_lo(xi[i].y) * bf_lo(gc[i].y), bf_hi(xi[i].y) * bf_hi(gc[i].y)} * mk; }
#pragma unroll
                    for (int r = 0; r < 8; ++r) {
                        const f32x4 gb = {bf_lo(gbu[r].x), bf_hi(gbu[r].x), bf_lo(gbu[r].y), bf_hi(gbu[r].y)};
                        const f32x4 y = gb * (w0 * uu[r] + w1 * uu[r + 1] + w2 * uu[r + 2] + cbv);
                        float ss = (y[0] * y[0] + y[1] * y[1]) + (y[2] * y[2] + y[3] * y[3]);
                        ss += __shfl_xor(ss, 1); ss += __shfl_xor(ss, 2); ss += __shfl_xor(ss, 4); ss += __shfl_xor(ss, 8);
                        const float rs = rsqrtf(ss * (1.f / 64.f) + EPS);
                        const f32x4 o = y * rs * ogv;
                        u32x2 w; w.x = pg8::cvt_pk_bf16(o[0], o[1]); w.y = pg8::cvt_pk_bf16(o[2], o[3]);
                        *(u32x2*)(MIX + (size_t)(mb0 + r) * D + 768 + 4 * lane) = w;
                    }
                }
              } }
#pragma unroll 1
            for (int which = 0; which < 2; ++which) {
                pg8::Gemm g{which ? P + 512 : P, (const bf16_t*)(wl + (which ? WO_UKV : WO_UQ)), M, which ? N_UKV : N_UQ, which ? K_UKV : K_UQ, 1536};
                pg8::StaticOrder S; S.init(M, g.N, G, bid);
                EpiHeads E{which ? KN : QN, which ? Vb : QR, which ? p.in[16] + l * 64 : p.in[15] + l * 64, SSQ2 + (size_t)(2 * l + which) * M,
                           which ? 1.f : 0.10206207261596575f * LOG2E, which ? 1.f / K_UKV : 1.f / K_UQ, which ? 512 : 256, 0};
                pg8::gemm_phase<EpiHeads, pg8::StaticOrder, true, true>(lds, g, S, E);
            }
        }
        SEAM(pb + 3);
        if (IN_PHL(4)) for (int rep_ = 0; rep_ <= ((REP_MASK >> 4) & 1); ++rep_) {
            const float* ong = p.in[21] + (size_t)l * D;
            for (int ui = vcu; ui < BATCH * 8 * 32; ui += G) {
                const int bh = ui >> 5, qb = ui & 31, b = bh >> 3, h = bh & 7;
                att::attn_unit<false>(lds, b, h, qb, QN, 512, QR, KN, 512, KR, Vb, 512, nullptr, ong + 256 + h * 64, MIX + 256 + h * 64, cosT, sinT, p.in[17] + l * 32, 0.10206207261596575f * LOG2E, p.in[16] + l * 64, p.in[18] + l * 32);
            }
            for (int ui = vcu; ui < BATCH * 4 * 32; ui += G) {
                const int bh = ui >> 5, gq = ui & 31, b = bh >> 2, h = bh & 3;
                att::attn_unit<true>(lds, b, h, gq, QNA, 256, nullptr, KNA, 256, nullptr, VNA, 256, p.in[10] + ((size_t)l * 4 + h) * 15 * 31, ong + h * 64, MIX + h * 64, nullptr, nullptr, nullptr, 0.f, p.in[9] + l * 64, nullptr);
            }
        }
        SEAM(pb + 4);
        if (IN_PHL(5)) for (int rep_ = 0; rep_ <= ((REP_MASK >> 5) & 1); ++rep_) {
            pg8::Gemm g{MIX, (const bf16_t*)(wl + WO_OUT), M, D, D, D}; pg8::StaticOrder S; S.init(M, D, G, bid);
            EpiRes E{xin, XA, modl + 2 * D, H, AVEC + (size_t)(2 * l + 1) * 4 * D, SSQ + (size_t)(2 * l + 1) * M};
            pg8::gemm_phase<EpiRes, pg8::StaticOrder, true, true>(lds, g, S, E);
        }
        SEAM(pb + 5);
        if (IN_PHL(7)) for (int rep_ = 0; rep_ <= ((REP_MASK >> 7) & 1); ++rep_) {
            pg8::Gemm g{H, (const bf16_t*)(wl + WO_GU), M, N_GU, D, D}; pg8::StaticOrder S; S.init(M, N_GU, G, bid);
            EpiGU E{ACT, SSQ + (size_t)(2 * l + 1) * M, BIASGU + (size_t)l * 4 * N_GU};
            pg8::gemm_phase<EpiGU, pg8::StaticOrder, true, true>(lds, g, S, E);
        }
        SEAM(pb + 7);
        if (IN_PHL(8)) for (int rep_ = 0; rep_ <= ((REP_MASK >> 8) & 1); ++rep_) {
            pg8::Gemm g{ACT, (const bf16_t*)(wl + WO_DOWN), M, D, DFF, DFF}; pg8::StaticOrder S; S.init(M, D, G, bid);
            EpiRes E{XA, p.out, modl + 5 * D, (l + 1 < DEPTH) ? H : nullptr, AVEC + (size_t)(2 * (l + 1)) * 4 * D, SSQ + (size_t)(2 * (l + 1)) * M};
            pg8::gemm_phase<EpiRes, pg8::StaticOrder, true, true>(lds, g, S, E);
        }
        SEAM(pb + 8);
    }
#undef IN_PH
#undef IN_PHL
#undef SEAM
}

#ifndef N_LAUNCH_MODE
#define N_LAUNCH_MODE 1
#endif
extern "C" void kernel_launch(void* const* d_in, const int* in_sizes, int n_in, void* d_out, int out_size, void* d_ws, size_t ws_size, hipStream_t stream) {
    static int grid = 0;
    if (grid == 0) {
        if (n_in != 25 || out_size != M * D || ws_size < WS_END) { fprintf(stderr, "kernel_launch: unexpected shapes (n_in %d out %d ws %zu)\n", n_in, out_size, ws_size); grid = -1; return; }
        int dev = 0, cus = 0, per_cu = 0;
        hipGetDevice(&dev); hipDeviceGetAttribute(&cus, hipDeviceAttributeMultiprocessorCount, dev);
        if (hipFuncSetAttribute((const void*)fwd_kernel, hipFuncAttributeMaxDynamicSharedMemorySize, LDS_BYTES) != hipSuccess) { fprintf(stderr, "kernel_launch: hipFuncSetAttribute failed\n"); grid = -1; return; }
        if (hipOccupancyMaxActiveBlocksPerMultiprocessor(&per_cu, (const void*)fwd_kernel, NTHREADS, LDS_BYTES) != hipSuccess || per_cu < 1) { fprintf(stderr, "kernel_launch: occupancy query says %d\n", per_cu); per_cu = 1; }
        (void)hipGetLastError();
        grid = cus;
    }
    if (grid < 0) return;
    Params p{};
    for (int i = 0; i < 25; ++i) p.in[i] = (const float*)d_in[i];
    p.out = (float*)d_out; p.ws = (unsigned char*)d_ws;
    for (int e = 0; e < 16; ++e) p.inv_freq[e] = (float)pow(10000.0, -(double)(2 * e) / 32.0);
#if N_LAUNCH_MODE == 1
    p.ph_lo = 0; p.ph_hi = NPHASES; p.coop = 1;
    void* args[] = {&p};
    hipError_t e = hipLaunchCooperativeKernel((const void*)fwd_kernel, dim3(grid), dim3(NTHREADS), args, LDS_BYTES, stream);
    if (e != hipSuccess) fprintf(stderr, "cooperative launch failed: %s (grid %d)\n", hipGetErrorString(e), grid);
#else
    for (int ph = 0; ph < NPHASES; ++ph) {
        p.ph_lo = ph; p.ph_hi = ph + 1; p.coop = 0;
        hipLaunchKernelGGL(fwd_kernel, dim3(grid), dim3(NTHREADS), LDS_BYTES, stream, p);
    }
#endif
}
```
